# Optimizing an MI355X kernel written in HIP

```python
import jax, jax.numpy as jnp
from jax import lax
import numpy as np

D_MODEL = 2048
BATCH = 4
SEQ = 4096
DEPTH = 2

NORM_EPS = 1e-6
MIX_WIDTH = D_MODEL
CONV_CH = MIX_WIDTH // 2
CONV_K = 3
GLA_HEADS = 4
GLA_DV = (MIX_WIDTH // 2) // GLA_HEADS
GLA_DK = GLA_DV // 2
GLA_GATE_RANK = 16
GLA_GATE_TEMP = 16.0
GLA_CHUNK = 64
ATTN_HEADS = 16
ATTN_HEAD_DIM = D_MODEL // ATTN_HEADS
DILATED_GROUPS = ((128, 1), (512, 4), (2048, 16))
ATTN_BLOCK = 128
D_FF = 4 * D_MODEL
N_EVEN = (DEPTH + 1) // 2
N_ODD = DEPTH // 2
IN_SIZES = (CONV_CH, CONV_CH, CONV_CH, GLA_HEADS * GLA_DK, GLA_HEADS * GLA_DK,
            GLA_HEADS * GLA_DV, GLA_HEADS * GLA_DV, GLA_GATE_RANK)
IN_OFFSETS = tuple(int(v) for v in np.cumsum(IN_SIZES)[:-1])
IN_COLS = sum(IN_SIZES)

kernel_name = "hybrid_conv_gla_dilated_trunk"


def rmsnorm(x, g):
    xf = x.astype(jnp.float32)
    xf = xf * lax.rsqrt(jnp.mean(xf * xf, axis=-1, keepdims=True) + NORM_EPS)
    return (xf * g.astype(jnp.float32)).astype(x.dtype)


def causal_short_conv(u, w):
    return lax.conv_general_dilated(
        u, w[:, None, :], window_strides=(1,), padding=[(CONV_K - 1, 0)],
        dimension_numbers=('NWC', 'WIO', 'NWC'), feature_group_count=u.shape[-1])


def gla_chunked(q, k, v, log_a):
    b, t, h, dk = q.shape
    dv = v.shape[-1]
    n = t // GLA_CHUNK

    def chunks(a):
        return a.astype(jnp.float32).reshape(b, n, GLA_CHUNK, h, a.shape[-1]).transpose(1, 0, 3, 2, 4)

    qc, kc, vc = chunks(q), chunks(k), chunks(v)
    gc = jnp.cumsum(chunks(log_a), axis=3)
    causal = jnp.tril(jnp.ones((GLA_CHUNK, GLA_CHUNK), dtype=bool))

    def step(state, inp):
        qi, ki, vi, gi = inp
        o_inter = jnp.einsum('bhck,bhkv->bhcv', qi * jnp.exp(gi), state)
        rel = gi[:, :, :, None, :] - gi[:, :, None, :, :]
        decay = jnp.exp(jnp.where(causal[:, :, None], rel, -jnp.inf))
        scores = jnp.einsum('bhik,bhijk,bhjk->bhij', qi, decay, ki)
        o_intra = jnp.einsum('bhij,bhjv->bhiv', scores, vi)
        g_last = gi[:, :, -1]
        k_dec = ki * jnp.exp(g_last[:, :, None] - gi)
        state = jnp.exp(g_last)[..., None] * state + jnp.einsum('bhjk,bhjv->bhkv', k_dec, vi)
        return state, o_inter + o_intra

    s0 = jnp.zeros((b, h, dk, dv), jnp.float32)
    _, o = lax.scan(step, s0, (qc, kc, vc, gc))
    return o.transpose(1, 0, 3, 2, 4).reshape(b, t, h, dv).astype(q.dtype)


def conv_gla_mixer(h, w_in, conv_w, w_gate2, b_gate, gla_norm_g, w_out):
    b, t, _ = h.shape
    a_b, a_c, a_x, q, k, v, r, g_low = jnp.split(h @ w_in, IN_OFFSETS, axis=-1)
    y_conv = a_b * causal_short_conv(a_c * a_x, conv_w)
    q = q.reshape(b, t, GLA_HEADS, GLA_DK) * (GLA_DK ** -0.5)
    k = k.reshape(b, t, GLA_HEADS, GLA_DK)
    v = v.reshape(b, t, GLA_HEADS, GLA_DV)
    log_a = jax.nn.log_sigmoid((g_low @ w_gate2 + b_gate).astype(jnp.float32)) / GLA_GATE_TEMP
    o = gla_chunked(q, k, v, log_a.reshape(b, t, GLA_HEADS, GLA_DK))
    o = rmsnorm(o, gla_norm_g) * jax.nn.silu(r.reshape(b, t, GLA_HEADS, GLA_DV))
    y = jnp.concatenate([y_conv, o.reshape(b, t, GLA_HEADS * GLA_DV)], axis=-1)
    return y @ w_out


def dilated_branch(q, k, v, slopes, window, dilation):
    b, t, h, dh = q.shape
    steps = window // dilation
    assert steps <= ATTN_BLOCK
    span = dilation * ATTN_BLOCK
    tp = -(-t // span) * span
    n_sub = tp // dilation
    nb = n_sub // ATTN_BLOCK

    def blocks(a):
        a = jnp.pad(a, ((0, 0), (0, tp - t), (0, 0), (0, 0)))
        a = a.reshape(b, n_sub, dilation, h, dh).transpose(0, 2, 3, 1, 4)
        return a.reshape(b, dilation, h, nb, ATTN_BLOCK, dh)

    def with_prev(a):
        prev = jnp.pad(a, ((0, 0), (0, 0), (0, 0), (1, 0), (0, 0), (0, 0)))[:, :, :, :-1]
        return jnp.concatenate([prev, a], axis=4)

    qb = blocks(q)
    kw, vw = with_prev(blocks(k)), with_prev(blocks(v))
    s = jnp.einsum('brhnqc,brhnkc->brhnqk', qb, kw).astype(jnp.float32) * (dh ** -0.5)
    qi = jnp.arange(ATTN_BLOCK)[:, None]
    ki = jnp.arange(2 * ATTN_BLOCK)[None, :]
    diff = ATTN_BLOCK + qi - ki
    band = (diff >= 0) & (diff <= steps)
    after_start = (jnp.arange(nb)[:, None, None] > 0) | (ki[None] >= ATTN_BLOCK)
    mask = band[None] & after_start
    alibi = -slopes[:, None, None] * (dilation * diff).astype(jnp.float32)[None]
    s = jnp.where(mask[None, None, None], s + alibi[None, None, :, None], -jnp.inf)
    m = jnp.max(s, axis=-1, keepdims=True)
    p = jnp.exp(s - m)
    z = jnp.sum(p, axis=-1, keepdims=True)
    o = jnp.einsum('brhnqk,brhnkc->brhnqc', p, vw.astype(jnp.float32)) / z
    lse = (m + jnp.log(z))[..., 0]
    o = o.reshape(b, dilation, h, n_sub, dh).transpose(0, 3, 1, 2, 4).reshape(b, tp, h, dh)[:, :t]
    lse = lse.reshape(b, dilation, h, n_sub).transpose(0, 3, 1, 2).reshape(b, tp, h)[:, :t]
    return o, lse


def dilated_attention(h, w_qkv, w_o):
    b, t, _ = h.shape
    qkv = (h @ w_qkv).reshape(b, t, 3, ATTN_HEADS, ATTN_HEAD_DIM)
    q, k, v = qkv[:, :, 0], qkv[:, :, 1], qkv[:, :, 2]
    slopes = jnp.exp2(-8.0 * jnp.arange(1, ATTN_HEADS + 1, dtype=jnp.float32) / ATTN_HEADS)
    outs, lses = zip(*[dilated_branch(q, k, v, slopes, win, dil) for win, dil in DILATED_GROUPS])
    wts = jax.nn.softmax(jnp.stack(lses), axis=0)
    o = jnp.sum(wts[..., None] * jnp.stack(outs), axis=0)
    return o.reshape(b, t, D_MODEL).astype(h.dtype) @ w_o


def squared_relu_mlp(h, w1, w2):
    return jnp.square(jax.nn.relu(h @ w1)) @ w2


def setup_inputs(seed: int = 0) -> dict:
    key = jax.random.key(seed)
    ks = jax.random.split(key, 14)
    nrm = jax.random.normal
    f32 = jnp.float32
    return {
        'x': nrm(ks[0], (BATCH, SEQ, D_MODEL), f32),
        'norm_mix_g': 1.0 + 0.01 * nrm(ks[1], (DEPTH, D_MODEL), f32),
        'norm_mlp_g': 1.0 + 0.01 * nrm(ks[2], (DEPTH, D_MODEL), f32),
        'final_norm_g': 1.0 + 0.01 * nrm(ks[3], (D_MODEL,), f32),
        'hyb_w_in': nrm(ks[4], (N_EVEN, D_MODEL, IN_COLS), f32) * D_MODEL ** -0.5,
        'conv_w': nrm(ks[5], (N_EVEN, CONV_K, CONV_CH), f32) * CONV_K ** -0.5,
        'gla_w_gate2': nrm(ks[6], (N_EVEN, GLA_GATE_RANK, GLA_HEADS * GLA_DK), f32) * GLA_GATE_RANK ** -0.5,
        'gla_b_gate': 0.01 * nrm(ks[7], (N_EVEN, GLA_HEADS * GLA_DK), f32),
        'gla_norm_g': 1.0 + 0.01 * nrm(ks[8], (N_EVEN, GLA_DV), f32),
        'hyb_w_out': nrm(ks[9], (N_EVEN, MIX_WIDTH, D_MODEL), f32) * MIX_WIDTH ** -0.5,
        'attn_w_qkv': nrm(ks[10], (N_ODD, D_MODEL, 3 * D_MODEL), f32) * D_MODEL ** -0.5,
        'attn_w_o': nrm(ks[11], (N_ODD, D_MODEL, D_MODEL), f32) * D_MODEL ** -0.5,
        'mlp_w1': nrm(ks[12], (DEPTH, D_MODEL, D_FF), f32) * D_MODEL ** -0.5,
        'mlp_w2': nrm(ks[13], (DEPTH, D_FF, D_MODEL), f32) * D_FF ** -0.5,
    }


def reference(x, norm_mix_g, norm_mlp_g, final_norm_g, hyb_w_in, conv_w, gla_w_gate2,
              gla_b_gate, gla_norm_g, hyb_w_out, attn_w_qkv, attn_w_o, mlp_w1, mlp_w2):
    for layer in range(DEPTH):
        h = rmsnorm(x, norm_mix_g[layer])
        if layer % 2 == 0:
            e = layer // 2
            mix = conv_gla_mixer(h, hyb_w_in[e], conv_w[e], gla_w_gate2[e], gla_b_gate[e],
                                 gla_norm_g[e], hyb_w_out[e])
        else:
            o = layer // 2
            mix = dilated_attention(h, attn_w_qkv[o], attn_w_o[o])
        x = x + mix
        x = x + squared_relu_mlp(rmsnorm(x, norm_mlp_g[layer]), mlp_w1[layer], mlp_w2[layer])
    return rmsnorm(x, final_norm_g)
```

```cpp
#include <hip/hip_runtime.h>
#include <cstdio>
#include <cstdint>
#include <cmath>
namespace pg8 {
#define PG8_LAS __attribute__((address_space(3)))
typedef unsigned short bf16_t;
typedef short bf16x8 __attribute__((ext_vector_type(8)));
typedef float f32x4 __attribute__((ext_vector_type(4)));
typedef unsigned u32x4 __attribute__((ext_vector_type(4)));
constexpr int BM = 256, BK = 64, HALF = 128, HTB = HALF * BK * 2  , STAGE_BYTES = 8 * HTB, NXCD = 8, WGM = 8;

__host__ __device__ __forceinline__ int lds_byte(int r, int c) { const int st = (r >> 4) * 2 + (c >> 5), rr = r & 15, cc = c & 31, ob = rr * 64 + cc * 2; return st * 1024 + (ob ^ (((ob >> 9) & 1) << 5)); }
__host__ __device__ __forceinline__ void stage_rc(int b, int& R, int& C) { const int st = b / 1024, sb = b % 1024, swz = sb ^ (((sb >> 9) & 1) << 5); R = (st >> 1) * 16 + swz / 64; C = (st & 1) * 32 + (swz % 64) / 2; }
__host__ __device__ __forceinline__ int perm32(int rho) { const int n = rho >> 4, i = rho & 15; return 8 * (i >> 2) + 4 * n + (i & 3); }

struct Unit { int pm, pn; };
struct Gemm { const bf16_t* A; const bf16_t* Bt; int M, N, K; };

struct StaticOrder {
    int nM, nN, nwg, G, c;
    __host__ __device__ void init(int M, int N, int G_, int c_) { nM = M / BM; nN = N / BM; nwg = nM * nN; G = G_; c = c_; }
    __host__ __device__ bool next(int i, Unit& u) const {
        const long L = (long)i * G + c; if (L >= nwg) return false;
        int wgid = (int)L; { const int q = nwg / NXCD, r = nwg % NXCD, xcd = wgid % NXCD, off = wgid / NXCD; wgid = (xcd < r ? xcd * (q + 1) : r * (q + 1) + (xcd - r) * q) + off; }
        const int nig = WGM * nN, gid = wgid / nig, fm = gid * WGM, gsz = (nM - fm) < WGM ? (nM - fm) : WGM;
        u.pm = fm + ((wgid % nig) % gsz); u.pn = (wgid % nig) / gsz; return true;
    }
    __device__ __forceinline__ void a_ready(const Unit&) const {}
    __device__ __forceinline__ void done(const Unit&) const {}
};
__device__ __forceinline__ unsigned cvt_pk_bf16(float lo, float hi) { unsigned r; asm volatile("v_cvt_pk_bf16_f32 %0, %1, %2" : "=v"(r) : "v"(lo), "v"(hi)); return r; }
typedef unsigned u32x2 __attribute__((ext_vector_type(2)));
constexpr float RMS_EPS = 1e-6f, INV_D = 1.0f / 2048.0f;

template <int MODE> struct EpiBf16S {
    static constexpr bool PERM = true, AFTER_DRAIN = false;
    bf16_t* O; int ldc; const float* ss;
    __device__ __forceinline__ void operator()(const f32x4 (&acc)[2][2][4][2], const Unit& u, int wr, int wc, int fr, int fq) const {
        const int row0 = u.pm * BM + wr * 64 + fr, col0 = u.pn * BM + wc * 32 + 8 * fq;
#pragma unroll
        for (int ai = 0; ai < 2; ++ai)
#pragma unroll
            for (int m = 0; m < 4; ++m) { const int row = row0 + ai * HALF + m * 16; bf16_t* rowp = O + (size_t)row * ldc + col0;
                float sc = 1.f; if (ss) sc = __builtin_amdgcn_rsqf(ss[row] * INV_D + RMS_EPS);
#pragma unroll
                for (int bj = 0; bj < 2; ++bj) { f32x4 v0 = acc[ai][bj][m][0], v1 = acc[ai][bj][m][1];
                    if (MODE == 1) {
#pragma unroll
                        for (int j = 0; j < 4; ++j) { float a = fmaxf(v0[j], 0.f) * sc, b = fmaxf(v1[j], 0.f) * sc; v0[j] = a * a; v1[j] = b * b; } }
                    else { v0 = v0 * sc; v1 = v1 * sc; }
                    u32x4 w; w.x = cvt_pk_bf16(v0[0], v0[1]); w.y = cvt_pk_bf16(v0[2], v0[3]); w.z = cvt_pk_bf16(v1[0], v1[1]); w.w = cvt_pk_bf16(v1[2], v1[3]);
                    *(u32x4*)(rowp + bj * HALF) = w; } }
    }
};
struct EpiResid {
    static constexpr bool PERM = false, AFTER_DRAIN = false;
    const float* base; float* out; bf16_t* An; const float* g; float* ss; int ldc;
    __device__ __forceinline__ void operator()(const f32x4 (&acc)[2][2][4][2], const Unit& u, int wr, int wc, int fr, int fq) const {
        const int row0 = u.pm * BM + wr * 64 + fr, col0 = u.pn * BM + wc * 32 + 4 * fq;
        f32x4 gv[2][2];
#pragma unroll
        for (int bj = 0; bj < 2; ++bj)
#pragma unroll
            for (int n = 0; n < 2; ++n) gv[bj][n] = An ? *(const f32x4*)(g + col0 + bj * HALF + n * 16) : (f32x4){0.f, 0.f, 0.f, 0.f};
#pragma unroll
        for (int ai = 0; ai < 2; ++ai)
#pragma unroll
            for (int m = 0; m < 4; ++m) { const int row = row0 + ai * HALF + m * 16; const size_t off = (size_t)row * ldc + col0; float s = 0.f;
#pragma unroll
                for (int bj = 0; bj < 2; ++bj)
#pragma unroll
                    for (int n = 0; n < 2; ++n) { const f32x4 bs = *(const f32x4*)(base + off + bj * HALF + n * 16); const f32x4 o = bs + acc[ai][bj][m][n];
                        *(f32x4*)(out + off + bj * HALF + n * 16) = o; s += (o[0] * o[0] + o[1] * o[1]) + (o[2] * o[2] + o[3] * o[3]);
                        if (An) { const f32x4 w = o * gv[bj][n]; u32x2 p; p.x = cvt_pk_bf16(w[0], w[1]); p.y = cvt_pk_bf16(w[2], w[3]); *(u32x2*)(An + off + bj * HALF + n * 16) = p; } }
                if (ss) { s += __shfl_xor(s, 16); s += __shfl_xor(s, 32); if (fq == 0) atomicAdd(ss + row, s); }
                asm volatile("" ::: "memory"); }
    }
};

template <class Epi, class Sched, bool ALIGN_EPI = false, bool SP2 = false>
__device__ __forceinline__ void gemm_phase(PG8_LAS unsigned char* lds, const Gemm g, const Sched& S, const Epi& E) {
    const int tid = threadIdx.x, wid = __builtin_amdgcn_readfirstlane(tid >> 6), lane = tid & 63, wr = wid >> 2, wc = wid & 3, fr = lane & 15, fq = lane >> 4;
    const int K = g.K, nt = K / BK;
    unsigned voffA[2], voffB[2];
#pragma unroll
    for (int i = 0; i < 2; ++i) { int R, C; stage_rc(tid * 16 + i * 8192, R, C); const int Rb = Epi::PERM ? ((R & ~31) + perm32(R & 31)) : R;
        voffA[i] = (unsigned)(R * K + C) * 2u; voffB[i] = (unsigned)(Rb * K + C) * 2u; }
    const size_t kstep = (size_t)(BK * 2);
    const size_t hstep = (size_t)HALF * K * 2;
    const size_t tstep = 2 * hstep;
    const unsigned ldsw = (unsigned)wid * 1024u;
    const int aoff = lds_byte(wr * 64 + fr, fq * 8), boff = lds_byte(wc * 32 + fr, fq * 8);
#define PG8_SA(b, h) (((b) * 2 + (h)) * HTB)
#define PG8_SB(b, h) ((4 + (b) * 2 + (h)) * HTB)
#define PG8_STAGE(bufoff, gbase, voff) do { _Pragma("unroll") for (int _i = 0; _i < 2; ++_i) \
        __builtin_amdgcn_global_load_lds((const unsigned*)((const char*)(gbase) + (voff)[_i]), (PG8_LAS unsigned*)(lds + (bufoff) + ldsw + _i * 8192), 16, 0, 0); } while (0)
#define PG8_LDA(dst, b, h) do { _Pragma("unroll") for (int m = 0; m < 4; ++m) _Pragma("unroll") for (int k = 0; k < 2; ++k) dst[m][k] = *(const PG8_LAS bf16x8*)(lds + PG8_SA(b, h) + aoff + m * 2048 + k * 1024); } while (0)
#define PG8_LDB(dst, b, h) do { _Pragma("unroll") for (int n = 0; n < 2; ++n) _Pragma("unroll") for (int k = 0; k < 2; ++k) dst[n][k] = *(const PG8_LAS bf16x8*)(lds + PG8_SB(b, h) + boff + n * 2048 + k * 1024); } while (0)
#define PG8_MMA(ai, bj, At, Bt) do { __builtin_amdgcn_s_setprio(1); _Pragma("unroll") for (int m = 0; m < 4; ++m) _Pragma("unroll") for (int n = 0; n < 2; ++n) _Pragma("unroll") for (int k = 0; k < 2; ++k) \
        acc[ai][bj][m][n] = __builtin_amdgcn_mfma_f32_16x16x32_bf16(Bt[n][k], At[m][k], acc[ai][bj][m][n], 0, 0, 0); __builtin_amdgcn_s_setprio(0); } while (0)
#define PG8_WAIT_V(n) asm volatile("s_waitcnt vmcnt(" #n ")" ::: "memory")
#define PG8_WAIT_L(n) asm volatile("s_waitcnt lgkmcnt(" #n ")" ::: "memory")
#define PG8_BAR __builtin_amdgcn_s_barrier()
#define PG8_SCHED __builtin_amdgcn_sched_barrier(0)
    Unit cur, nxt; int ui = 0;
    if (!S.next(0, cur)) return;
    f32x4 acc[2][2][4][2];
#pragma unroll
    for (int a = 0; a < 2; ++a)
#pragma unroll
        for (int b = 0; b < 2; ++b)
#pragma unroll
            for (int m = 0; m < 4; ++m)
#pragma unroll
                for (int n = 0; n < 2; ++n) acc[a][b][m][n] = (f32x4){0.f, 0.f, 0.f, 0.f};
    bf16x8 At[4][2], B0[2][2], B1[2][2];
    const char* cA = (const char*)g.A + (size_t)cur.pm * tstep; const char* cB = (const char*)g.Bt + (size_t)cur.pn * tstep;
    S.a_ready(cur);
    if constexpr (SP2) {
        PG8_STAGE(PG8_SB(0, 0), cB, voffB); PG8_STAGE(PG8_SB(0, 1), cB + hstep, voffB); PG8_STAGE(PG8_SA(0, 0), cA, voffA); PG8_STAGE(PG8_SA(0, 1), cA + hstep, voffA);
        if (wr == 1) PG8_BAR;
        PG8_WAIT_V(2); PG8_BAR;
        PG8_STAGE(PG8_SB(1, 0), cB + kstep, voffB); PG8_STAGE(PG8_SA(1, 0), cA + kstep, voffA); PG8_STAGE(PG8_SB(1, 1), cB + hstep + kstep, voffB);
        PG8_WAIT_V(6); PG8_BAR;
    } else {
        PG8_STAGE(PG8_SB(0, 0), cB, voffB); PG8_STAGE(PG8_SA(0, 0), cA, voffA); PG8_STAGE(PG8_SB(0, 1), cB + hstep, voffB); PG8_STAGE(PG8_SA(0, 1), cA + hstep, voffA);
        if (wr == 1) PG8_BAR;
        PG8_WAIT_V(4); PG8_BAR;
        PG8_STAGE(PG8_SB(1, 0), cB + kstep, voffB); PG8_STAGE(PG8_SA(1, 0), cA + kstep, voffA); PG8_STAGE(PG8_SB(1, 1), cB + hstep + kstep, voffB);
        PG8_WAIT_V(6); PG8_BAR;
    }
    for (;;) {
        const bool has_next = S.next(ui + 1, nxt);
        const char* nA = has_next ? (const char*)g.A + (size_t)nxt.pm * tstep : cA; const char* nB = has_next ? (const char*)g.Bt + (size_t)nxt.pn * tstep : cB;
        for (int t = 0; t < nt; t += 2) {
            const bool last = (t == nt - 2);
            const char* a1 = cA + (size_t)(t + 1) * kstep;
            const char* a2 = last ? nA : cA + (size_t)(t + 2) * kstep; const char* b2 = last ? nB : cB + (size_t)(t + 2) * kstep;
            const char* a3 = a2 + kstep; const char* b3 = b2 + kstep;
            if (last && has_next) S.a_ready(nxt);
            if constexpr (SP2) {
            PG8_LDB(B0, 0, 0); PG8_LDB(B1, 0, 1); PG8_SCHED; PG8_LDA(At, 0, 0); PG8_STAGE(PG8_SA(1, 1), a1 + hstep, voffA);
            PG8_WAIT_V(8); PG8_WAIT_L(0); PG8_BAR; PG8_MMA(0, 0, At, B0); PG8_MMA(0, 1, At, B1); PG8_BAR; PG8_SCHED;
            PG8_LDA(At, 0, 1); PG8_STAGE(PG8_SB(0, 0), b2, voffB); PG8_STAGE(PG8_SB(0, 1), b2 + hstep, voffB); PG8_STAGE(PG8_SA(0, 0), a2, voffA);
            PG8_WAIT_V(8); PG8_WAIT_L(0); PG8_BAR; PG8_MMA(1, 0, At, B0); PG8_MMA(1, 1, At, B1); PG8_BAR; PG8_SCHED;
            PG8_LDB(B0, 1, 0); PG8_LDB(B1, 1, 1); PG8_SCHED; PG8_LDA(At, 1, 0); PG8_STAGE(PG8_SA(0, 1), a2 + hstep, voffA);
            PG8_WAIT_V(8); PG8_WAIT_L(0); PG8_BAR; PG8_MMA(0, 0, At, B0); PG8_MMA(0, 1, At, B1); PG8_BAR; PG8_SCHED;
            PG8_LDA(At, 1, 1); PG8_STAGE(PG8_SB(1, 0), b3, voffB); PG8_STAGE(PG8_SB(1, 1), b3 + hstep, voffB); PG8_STAGE(PG8_SA(1, 0), a3, voffA);
            PG8_WAIT_V(8); PG8_WAIT_L(0); PG8_BAR; PG8_MMA(1, 0, At, B0); PG8_MMA(1, 1, At, B1); PG8_BAR; PG8_SCHED;
            } else {
            PG8_LDB(B0, 0, 0); PG8_SCHED; PG8_LDA(At, 0, 0); PG8_STAGE(PG8_SA(1, 1), a1 + hstep, voffA);
            PG8_WAIT_L(8); PG8_BAR; PG8_WAIT_L(0); PG8_MMA(0, 0, At, B0); PG8_BAR; PG8_SCHED;
            PG8_LDB(B1, 0, 1); PG8_STAGE(PG8_SB(0, 0), b2, voffB);
            PG8_BAR; PG8_WAIT_L(0); PG8_MMA(0, 1, At, B1); PG8_BAR;
            PG8_LDA(At, 0, 1); PG8_STAGE(PG8_SA(0, 0), a2, voffA);
            PG8_BAR; PG8_WAIT_L(0); PG8_MMA(1, 0, At, B0); PG8_BAR; PG8_SCHED;
            PG8_STAGE(PG8_SB(0, 1), b2 + hstep, voffB);
            PG8_WAIT_V(6); PG8_BAR; PG8_MMA(1, 1, At, B1); PG8_BAR;
            PG8_LDB(B0, 1, 0); PG8_SCHED; PG8_LDA(At, 1, 0); PG8_STAGE(PG8_SA(0, 1), a2 + hstep, voffA);
            PG8_WAIT_L(8); PG8_BAR; PG8_WAIT_L(0); PG8_MMA(0, 0, At, B0); PG8_BAR; PG8_SCHED;
            PG8_LDB(B1, 1, 1); PG8_STAGE(PG8_SB(1, 0), b3, voffB);
            PG8_BAR; PG8_WAIT_L(0); PG8_MMA(0, 1, At, B1); PG8_BAR;
            PG8_LDA(At, 1, 1); PG8_STAGE(PG8_SA(1, 0), a3, voffA);
            PG8_BAR; PG8_WAIT_L(0); PG8_MMA(1, 0, At, B0); PG8_BAR; PG8_SCHED;
            PG8_STAGE(PG8_SB(1, 1), b3 + hstep, voffB);
            PG8_WAIT_V(6); PG8_BAR; PG8_MMA(1, 1, At, B1); PG8_BAR;
            }
        }
        if constexpr (ALIGN_EPI) { if (wr == 0) PG8_BAR; }
        if constexpr (!Epi::AFTER_DRAIN) { E(acc, cur, wr, wc, fr, fq); S.done(cur); }
        if (!has_next) break;
#pragma unroll
        for (int a = 0; a < 2; ++a)
#pragma unroll
            for (int b = 0; b < 2; ++b)
#pragma unroll
                for (int m = 0; m < 4; ++m)
#pragma unroll
                    for (int n = 0; n < 2; ++n) acc[a][b][m][n] = (f32x4){0.f, 0.f, 0.f, 0.f};
        cur = nxt; cA = nA; cB = nB; ++ui;
        if constexpr (ALIGN_EPI) { if (wr == 1) PG8_BAR; }
    }
    PG8_WAIT_V(0);
    if constexpr (!ALIGN_EPI) { if (wr == 0) PG8_BAR; }
    PG8_BAR;
    if constexpr (Epi::AFTER_DRAIN) { E.fused(acc, cur, wr, wc, fr, fq, lds, wid, lane); S.done(cur); }
#undef PG8_SA
#undef PG8_SB
#undef PG8_STAGE
#undef PG8_LDA
#undef PG8_LDB
#undef PG8_MMA
#undef PG8_WAIT_V
#undef PG8_WAIT_L
#undef PG8_BAR
#undef PG8_SCHED
}
}
#ifndef PG8_SP2
#define PG8_SP2 true
#endif
#ifndef PG8_ALIGN
#define PG8_ALIGN true
#endif
#ifndef MK_PER_PHASE
#define MK_PER_PHASE 1
#endif
constexpr int NWAVES = 8;
constexpr int BATCH = 4, T = 4096, D = 2048, M = BATCH * T, FF = 8192, NPROJ = 6144, INCOLS = 6160;
constexpr int O_CB = 0, O_CC = 1024, O_CX = 2048, O_Q = 3072, O_K = 3584, O_V = 4096, O_R = 5120, O_GL = 6144;
constexpr float EPS = 1e-6f;
constexpr int NPHASE = 14;

constexpr size_t MiB = 1u << 20;
constexpr size_t WS_CTL = 0, CTL_ZERO_BYTES = 1 * MiB;
constexpr size_t WS_GLOW = 1 * MiB;
constexpr size_t WS_WA = 2 * MiB;
constexpr size_t WS_WB = 34 * MiB;
constexpr size_t WS_WC = 98 * MiB;
constexpr size_t WS_ACT = 162 * MiB;
constexpr size_t WS_Y = 226 * MiB;
constexpr size_t WS_PROJ = 290 * MiB;
constexpr size_t WS_H = WS_Y;
constexpr size_t WS_END = 482 * MiB;
static_assert(WS_H + (size_t)M * FF * 2 == WS_END && WS_PROJ + (size_t)M * NPROJ * 2 == WS_END, "ws map");
constexpr int CW_BAR = 4096;
constexpr size_t SS_OFF = 256 * 1024;
static_assert(SS_OFF + 4 * (size_t)M * 4 <= CTL_ZERO_BYTES, "ss inside the memset region");

constexpr int RING_OFF = 0, RING_BYTES = 131072;
constexpr int LDSCTL_OFF = RING_BYTES, MISC_OFF = LDSCTL_OFF + 320;
constexpr int LDS_BYTES = 147456;
static_assert(MISC_OFF + 128 <= LDS_BYTES, "LDS map");

#define GAS __attribute__((address_space(1)))
#define LAS __attribute__((address_space(3)))
typedef unsigned short bf16;
typedef unsigned v4u __attribute__((ext_vector_type(4)));
typedef float f32x4 __attribute__((ext_vector_type(4)));
typedef short bf16x8 __attribute__((ext_vector_type(8)));
typedef GAS unsigned gu32;
typedef GAS unsigned long long gu64;
#define RLX_AGENT __ATOMIC_RELAXED, __HIP_MEMORY_SCOPE_AGENT
#define LDS_WAIT() asm volatile("s_waitcnt lgkmcnt(0)" ::: "memory")
#define VM_WAIT() asm volatile("s_waitcnt vmcnt(0)" ::: "memory")
__device__ __forceinline__ unsigned long long rt() { return __builtin_amdgcn_s_memrealtime(); }
__device__ __forceinline__ unsigned f2bf(float f) { unsigned u = __builtin_bit_cast(unsigned, f); return (u + 0x7fffu + ((u >> 16) & 1u)) >> 16; }
__device__ __forceinline__ unsigned pk2(float lo, float hi) { return f2bf(lo) | (f2bf(hi) << 16); }

#define XB_TMO      128
#define XB_XCNT(j)  (256  + 64 * (j))
#define XB_XSUB(j)  (1280 + 64 * (j))
#define XB_XGEN(j)  (2304 + 64 * (j))
#define XB_TOP      3328
#define XB_TOPGEN   3392
#define XCD_BAR_WORDS 3456
#define XB_SPIN_CAP (1u << 18)

__device__ __forceinline__ unsigned xb_ld(unsigned* p)              { return __hip_atomic_load(p, __ATOMIC_RELAXED, __HIP_MEMORY_SCOPE_AGENT); }
__device__ __forceinline__ unsigned xb_add(unsigned* p, unsigned v) { return __hip_atomic_fetch_add(p, v, __ATOMIC_RELAXED, __HIP_MEMORY_SCOPE_AGENT); }
__device__ __forceinline__ unsigned xb_xcc_id() { return (unsigned)__builtin_amdgcn_s_getreg((3 << 11) | 20) & 0xFu; }
#define XB_SPIN(cond, bar) do { unsigned _sp = 0; while (cond) { __builtin_amdgcn_s_sleep(1); \
    if ((++_sp & 255u) == 0u) { if (xb_ld(&(bar)[XB_TMO])) break; if (_sp > XB_SPIN_CAP) { atomicAdd(&(bar)[XB_TMO], 1u); break; } } } } while (0)

struct XcdBarrier {
    unsigned* bar; unsigned x;
    volatile LAS unsigned* st;
};

__device__ __forceinline__ XcdBarrier xcd_barrier_post(unsigned* bar, volatile LAS unsigned* st) {
    XcdBarrier b; b.bar = bar; b.x = xb_xcc_id(); b.st = st;
    if (threadIdx.x == 0) (void)xb_add(&bar[XB_XCNT(b.x)], 1u);
    return b;
}
__device__ __forceinline__ void xcd_barrier_complete(unsigned* bar, unsigned x, unsigned& nloc, unsigned& nx) {
    const unsigned G = gridDim.x * gridDim.y * gridDim.z;
    unsigned sum, cnt, mine, sp = 0u;
    for (;;) {
        sum = 0u; cnt = 0u; mine = 0u;
#pragma unroll
        for (unsigned j = 0; j < 16; ++j) { const unsigned c = xb_ld(&bar[XB_XCNT(j)]); sum += c; cnt += (c > 0u) ? 1u : 0u; mine = (j == x) ? c : mine; }
        if (sum == G) break;
        __builtin_amdgcn_s_sleep(1);
        if ((++sp & 255u) == 0u) { if (xb_ld(&bar[XB_TMO])) break; if (sp > XB_SPIN_CAP) { atomicAdd(&bar[XB_TMO], 1u); break; } }
    }
    nloc = mine > 0u ? mine : 1u; nx = cnt > 0u ? cnt : 1u;
}

__device__ __forceinline__ void xcd_barrier(const XcdBarrier& b) {
    asm volatile("s_waitcnt vmcnt(0)" ::: "memory");
    __syncthreads();
    if (threadIdx.x == 0) {
        unsigned* bar = b.bar;
        __builtin_amdgcn_s_waitcnt(0);
        unsigned nloc = b.st[0], nx = b.st[1];
        if (nloc == 0u) { xcd_barrier_complete(bar, b.x, nloc, nx); b.st[0] = nloc; b.st[1] = nx; }
        const unsigned old = xb_add(&bar[XB_XSUB(b.x)], 1u);
        const unsigned gen = old / nloc;
        if (old + 1u == (gen + 1u) * nloc) {
            __builtin_amdgcn_fence(__ATOMIC_RELEASE, "agent");
            asm volatile("s_waitcnt vmcnt(0)" ::: "memory");
            const unsigned og = xb_add(&bar[XB_TOP], 1u);
            const unsigned tg = og / nx;
            if (og + 1u == (tg + 1u) * nx) xb_add(&bar[XB_TOPGEN], 1u);
            else XB_SPIN(xb_ld(&bar[XB_TOPGEN]) == tg, bar);
            __builtin_amdgcn_fence(__ATOMIC_ACQUIRE, "agent");
            xb_add(&bar[XB_XGEN(b.x)], 1u);
            asm volatile("s_waitcnt vmcnt(0)" ::: "memory");
        } else {
            XB_SPIN(xb_ld(&bar[XB_XGEN(b.x)]) == gen, bar);
            __builtin_amdgcn_fence(__ATOMIC_ACQUIRE, "agent");
            asm volatile("s_waitcnt vmcnt(0)" ::: "memory");
        }
    }
    __syncthreads();
}

struct Frame {
    LAS unsigned char* lds;
    volatile LAS unsigned* MISC;
    gu32* ctl;
    int tid, lane, wave;
    int vcu, G;
    const float* in[14];
    float* out; unsigned char* ws;
};
__device__ __forceinline__ float bf2f(unsigned short b) { return __uint_as_float(((unsigned)b) << 16); }
__device__ __forceinline__ float bflo(unsigned w) { return __uint_as_float(w << 16); }
__device__ __forceinline__ float bfhi(unsigned w) { return __uint_as_float(w & 0xffff0000u); }
__device__ __forceinline__ float wave_sum(float v) {
#pragma unroll
    for (int o = 1; o < 64; o <<= 1) v += __shfl_xor(v, o);
    return v;
}
__device__ __forceinline__ float wave_max(float v) {
#pragma unroll
    for (int o = 1; o < 64; o <<= 1) v = fmaxf(v, __shfl_xor(v, o));
    return v;
}
__device__ __forceinline__ void p0_transpose_item(const float* W, int K, int N, int ldw, bf16* WT, LAS float* scr, int item, int lane) {
    const int nblk = N / 32, kb = item / nblk, nb = item % nblk, k0 = 64 * kb, n0 = 32 * nb;
#pragma unroll 8
    for (int i = 0; i < 32; ++i) { const int kk = 2 * i + (lane >> 5); scr[kk * 33 + (lane & 31)] = W[(size_t)(k0 + kk) * ldw + n0 + (lane & 31)]; }
    LDS_WAIT(); asm volatile("" ::: "memory");
    const int c = lane & 7;
#pragma unroll
    for (int j = 0; j < 4; ++j) { const int n = (lane >> 3) + 8 * j; const LAS float* s = scr + (8 * c) * 33 + n;
        v4u o; o.x = pk2(s[0 * 33], s[1 * 33]); o.y = pk2(s[2 * 33], s[3 * 33]); o.z = pk2(s[4 * 33], s[5 * 33]); o.w = pk2(s[6 * 33], s[7 * 33]);
        *(GAS v4u*)(WT + (size_t)(n0 + n) * K + k0 + 8 * c) = o; }
    LDS_WAIT(); asm volatile("" ::: "memory");
}
__device__ __forceinline__ void transpose_all(Frame& F, const float* W, int K, int N, int ldw, bf16* WT) {
    LAS float* scr = (LAS float*)(F.lds + RING_OFF + F.wave * 16384);
    const int gw = F.vcu * NWAVES + F.wave, NGW = F.G * NWAVES, nitems = (K / 64) * (N / 32);
    for (int it = gw; it < nitems; it += NGW) p0_transpose_item(W, K, N, ldw, WT, scr, it, F.lane);
}

__device__ __forceinline__ void p0_prologue(Frame& F) {
    const float* w_in = F.in[4]; const float* w_out = F.in[9]; const float* w1 = F.in[12]; const float* w2 = F.in[13];
    transpose_all(F, w_in, D, NPROJ, INCOLS, (bf16*)(F.ws + WS_WA));
    transpose_all(F, w_out, D, D, D, (bf16*)(F.ws + WS_WA + 24 * MiB));
    transpose_all(F, w1, D, FF, FF, (bf16*)(F.ws + WS_WB));
    transpose_all(F, w2, FF, D, D, (bf16*)(F.ws + WS_WB + 32 * MiB));
    transpose_all(F, w1 + (size_t)D * FF, D, FF, FF, (bf16*)(F.ws + WS_WC));
    transpose_all(F, w2 + (size_t)D * FF, FF, D, D, (bf16*)(F.ws + WS_WC + 32 * MiB));
    const int gw = F.vcu * NWAVES + F.wave, NGW = F.G * NWAVES;
    const float* x = F.in[0]; const float* g = F.in[1];
    bf16* XN = (bf16*)(F.ws + WS_ACT); float* GL = (float*)(F.ws + WS_GLOW);
    for (int m = gw; m < M; m += NGW) {
        const GAS f32x4* xr = (const GAS f32x4*)(x + (size_t)m * D) + F.lane;
        f32x4 v[8]; float s = 0.f;
#pragma unroll
        for (int j = 0; j < 8; ++j) { v[j] = xr[64 * j]; s += (v[j].x * v[j].x + v[j].y * v[j].y) + (v[j].z * v[j].z + v[j].w * v[j].w); }
        const float rstd = 1.0f / sqrtf(wave_sum(s) * (1.f / D) + EPS);
        GAS unsigned long long* o8 = (GAS unsigned long long*)(XN + (size_t)m * D) + F.lane;
        float gl[16];
#pragma unroll
        for (int c = 0; c < 16; ++c) gl[c] = 0.f;
#pragma unroll
        for (int j = 0; j < 8; ++j) { const f32x4 gg = *((const GAS f32x4*)g + F.lane + 64 * j); v[j] = v[j] * gg * rstd;
            o8[64 * j] = (unsigned long long)pk2(v[j].x, v[j].y) | ((unsigned long long)pk2(v[j].z, v[j].w) << 32);
#pragma unroll
            for (int e = 0; e < 4; ++e) { const GAS f32x4* wr = (const GAS f32x4*)(w_in + (size_t)(4 * F.lane + 256 * j + e) * INCOLS + O_GL); const float hv = v[j][e];
#pragma unroll
                for (int c4 = 0; c4 < 4; ++c4) { const f32x4 wv = wr[c4]; gl[4 * c4 + 0] += hv * wv.x; gl[4 * c4 + 1] += hv * wv.y; gl[4 * c4 + 2] += hv * wv.z; gl[4 * c4 + 3] += hv * wv.w; } } }
#pragma unroll
        for (int c = 0; c < 16; ++c) gl[c] = wave_sum(gl[c]);
        float mine = 0.f;
#pragma unroll
        for (int c = 0; c < 16; ++c) mine = (F.lane == c) ? gl[c] : mine;
        if (F.lane < 16) GL[(size_t)m * 16 + F.lane] = mine;
    }
}
__device__ __forceinline__ void gla_gates(Frame& F) {
    const float* wg2 = F.in[6]; const float* bg = F.in[7]; const float* GL = (const float*)(F.ws + WS_GLOW); float* A = (float*)(F.ws + WS_ACT);
    const size_t n = (size_t)M * 512, stride = (size_t)F.G * NWAVES * 64;
    for (size_t i = (size_t)blockIdx.x * NWAVES * 64 + F.tid; i < n; i += stride) { const int m = (int)(i >> 9), c = (int)(i & 511);
        float xx = bg[c];
#pragma unroll
        for (int j = 0; j < 16; ++j) xx += GL[(size_t)m * 16 + j] * wg2[j * 512 + c];
        const float ls = fminf(xx, 0.f) - log1pf(expf(-fabsf(xx)));
        A[i] = expf(ls * (1.0f / 16.0f)); }
}
__device__ __forceinline__ void gla_recurrence(Frame& F) {
    const bf16* PROJ = (const bf16*)(F.ws + WS_PROJ); const float* A = (const float*)(F.ws + WS_ACT); float* ORAW = F.out;
    const float qs = 0.08838834764831845f;
    for (int u = blockIdx.x; u < 512; u += F.G) { const int b = u >> 7, h = (u >> 5) & 3, col = (u & 31) * 8 + F.wave;
        float s0 = 0.f, s1 = 0.f;
#pragma unroll 4
        for (int t = 0; t < T; ++t) { const size_t m = (size_t)b * T + t; const bf16* row = PROJ + m * NPROJ;
            const float a0 = A[m * 512 + h * 128 + F.lane], a1 = A[m * 512 + h * 128 + 64 + F.lane];
            const float k0 = bf2f(row[O_K + h * 128 + F.lane]), k1 = bf2f(row[O_K + h * 128 + 64 + F.lane]);
            const float q0 = bf2f(row[O_Q + h * 128 + F.lane]) * qs, q1 = bf2f(row[O_Q + h * 128 + 64 + F.lane]) * qs;
            const float v = bf2f(row[O_V + h * 256 + col]);
            s0 = a0 * s0 + k0 * v; s1 = a1 * s1 + k1 * v;
            const float p = wave_sum(q0 * s0 + q1 * s1);
            if (F.lane == 0) ORAW[m * 1024 + h * 256 + col] = p; } }
}
__device__ __forceinline__ void conv_mix(Frame& F) {
    const bf16* PROJ = (const bf16*)(F.ws + WS_PROJ); bf16* Y = (bf16*)(F.ws + WS_Y); const float* cw = F.in[5];
    const size_t n = (size_t)M * 512, stride = (size_t)F.G * NWAVES * 64;
    for (size_t i = (size_t)blockIdx.x * NWAVES * 64 + F.tid; i < n; i += stride) { const int m = (int)(i >> 9), c = (int)(i & 511) * 2, t = m & (T - 1);
        const bf16* row = PROJ + (size_t)m * NPROJ;
        const unsigned ab = *(const unsigned*)(row + O_CB + c);
        float u0[3], u1[3];
#pragma unroll
        for (int d = 0; d < 3; ++d) { if (t - d >= 0) { const bf16* r2 = row - (size_t)d * NPROJ; const unsigned ac = *(const unsigned*)(r2 + O_CC + c), ax = *(const unsigned*)(r2 + O_CX + c);
                u0[d] = bflo(ac) * bflo(ax); u1[d] = bfhi(ac) * bfhi(ax); } else { u0[d] = 0.f; u1[d] = 0.f; } }
        const float y0 = bflo(ab) * (cw[c] * u0[2] + cw[1024 + c] * u0[1] + cw[2048 + c] * u0[0]);
        const float y1 = bfhi(ab) * (cw[c + 1] * u1[2] + cw[1024 + c + 1] * u1[1] + cw[2048 + c + 1] * u1[0]);
        *(unsigned*)(Y + (size_t)m * D + c) = pk2(y0, y1); }
}
__device__ __forceinline__ void gla_finalize(Frame& F) {
    const bf16* PROJ = (const bf16*)(F.ws + WS_PROJ); bf16* Y = (bf16*)(F.ws + WS_Y); const float* ORAW = F.out; const float* gn = F.in[8];
    const int gw = F.vcu * NWAVES + F.wave, NGW = F.G * NWAVES;
    const f32x4 gv = *((const f32x4*)gn + F.lane);
    for (int i = gw; i < M * 4; i += NGW) { const int m = i >> 2, h = i & 3;
        const f32x4 o = *((const f32x4*)(ORAW + (size_t)m * 1024 + h * 256) + F.lane);
        const float ss = wave_sum((o.x * o.x + o.y * o.y) + (o.z * o.z + o.w * o.w)); const float rstd = 1.0f / sqrtf(ss * (1.f / 256.f) + EPS);
        const unsigned long long rr = *((const unsigned long long*)(PROJ + (size_t)m * NPROJ + O_R + h * 256) + F.lane);
        const float r0 = bflo((unsigned)rr), r1 = bfhi((unsigned)rr), r2 = bflo((unsigned)(rr >> 32)), r3 = bfhi((unsigned)(rr >> 32));
        const float y0 = o.x * rstd * gv.x * (r0 / (1.f + expf(-r0))), y1 = o.y * rstd * gv.y * (r1 / (1.f + expf(-r1)));
        const float y2 = o.z * rstd * gv.z * (r2 / (1.f + expf(-r2))), y3 = o.w * rstd * gv.w * (r3 / (1.f + expf(-r3)));
        *((unsigned long long*)(Y + (size_t)m * D + 1024 + h * 256) + F.lane) = (unsigned long long)pk2(y0, y1) | ((unsigned long long)pk2(y2, y3) << 32); }
}
__device__ __forceinline__ void attn_naive(Frame& F) {
    const bf16* PROJ = (const bf16*)(F.ws + WS_PROJ); bf16* Y = (bf16*)(F.ws + WS_Y);
    LAS float* qs = (LAS float*)(F.lds + RING_OFF + F.wave * 4096);
    LAS float* pl = qs + 128;
    const int gw = F.vcu * NWAVES + F.wave, NGW = F.G * NWAVES;
    for (int i = gw; i < M * 16; i += NGW) { const int h = i / M, m = i % M, b = m / T, t = m % T;
        const float slope = exp2f(-0.5f * (float)(h + 1));
        { const unsigned qq = *((const unsigned*)(PROJ + (size_t)m * NPROJ + h * 128) + F.lane); qs[2 * F.lane] = bflo(qq) * 0.08838834764831845f; qs[2 * F.lane + 1] = bfhi(qq) * 0.08838834764831845f; }
        LDS_WAIT(); asm volatile("" ::: "memory");
        float sc[3][3]; float mx = -INFINITY;
#pragma unroll
        for (int g = 0; g < 3; ++g) { const int dil = (g == 0) ? 1 : (g == 1 ? 4 : 16);
#pragma unroll
            for (int r = 0; r < 3; ++r) { const int j = F.lane + 64 * r; const int pos = t - j * dil; float s = -INFINITY;
                if (j <= 128 && pos >= 0) { const v4u* kr = (const v4u*)(PROJ + (size_t)(b * T + pos) * NPROJ + 2048 + h * 128); float a = 0.f;
#pragma unroll 4
                    for (int c = 0; c < 16; ++c) { const v4u kk = kr[c]; const LAS float* qp = qs + 8 * c;
                        a += qp[0] * bflo(kk.x) + qp[1] * bfhi(kk.x) + qp[2] * bflo(kk.y) + qp[3] * bfhi(kk.y) + qp[4] * bflo(kk.z) + qp[5] * bfhi(kk.z) + qp[6] * bflo(kk.w) + qp[7] * bfhi(kk.w); }
                    s = a - slope * (float)(dil * j); }
                sc[g][r] = s; mx = fmaxf(mx, s); } }
        mx = wave_max(mx);
        float z = 0.f;
#pragma unroll
        for (int g = 0; g < 3; ++g)
#pragma unroll
            for (int r = 0; r < 3; ++r) { const int j = F.lane + 64 * r; const float p = (sc[g][r] == -INFINITY) ? 0.f : expf(sc[g][r] - mx); z += p; if (j <= 128) pl[g * 132 + j] = p; }
        z = wave_sum(z);
        LDS_WAIT(); asm volatile("" ::: "memory");
        float o0 = 0.f, o1 = 0.f;
#pragma unroll
        for (int g = 0; g < 3; ++g) { const int dil = (g == 0) ? 1 : (g == 1 ? 4 : 16); int nj = t / dil + 1; if (nj > 129) nj = 129;
            const bf16* vb = PROJ + (size_t)(b * T + t) * NPROJ + 4096 + h * 128 + 2 * F.lane;
#pragma unroll 4
            for (int j = 0; j < nj; ++j) { const unsigned vv = *(const unsigned*)(vb - (size_t)j * dil * NPROJ); const float p = pl[g * 132 + j]; o0 += p * bflo(vv); o1 += p * bfhi(vv); } }
        const float iz = 1.0f / z;
        *((unsigned*)(Y + (size_t)m * D + h * 128) + F.lane) = pk2(o0 * iz, o1 * iz);
        LDS_WAIT(); asm volatile("" ::: "memory"); }
}
__device__ __forceinline__ void final_norm(Frame& F) {
    const float* g = F.in[3]; const int gw = F.vcu * NWAVES + F.wave, NGW = F.G * NWAVES;
    for (int m = gw; m < M; m += NGW) { GAS f32x4* xr = (GAS f32x4*)(F.out + (size_t)m * D) + F.lane;
        f32x4 v[8]; float s = 0.f;
#pragma unroll
        for (int j = 0; j < 8; ++j) { v[j] = xr[64 * j]; s += (v[j].x * v[j].x + v[j].y * v[j].y) + (v[j].z * v[j].z + v[j].w * v[j].w); }
        const float rstd = 1.0f / sqrtf(wave_sum(s) * (1.f / D) + EPS);
#pragma unroll
        for (int j = 0; j < 8; ++j) { const f32x4 gg = *((const GAS f32x4*)g + F.lane + 64 * j); xr[64 * j] = v[j] * gg * rstd; } }
}

struct Args { const float* in[14]; float* out; unsigned char* ws; int ph_lo, ph_hi; };
__global__ void __launch_bounds__(NWAVES * 64, 2) mk_fwd(Args args) {
    extern __shared__ __attribute__((aligned(16))) unsigned char lds[];
    Frame F;
    F.lds = (LAS unsigned char*)lds;
    F.MISC = (volatile LAS unsigned*)(F.lds + MISC_OFF);
    F.tid = threadIdx.x; F.lane = F.tid & 63; F.wave = __builtin_amdgcn_readfirstlane(F.tid >> 6);
    F.G = gridDim.x; { const int bx = blockIdx.x; F.vcu = (F.G % 8 == 0) ? (bx % 8) * (F.G / 8) + bx / 8 : bx; }
    F.ws = args.ws; F.out = args.out; F.ctl = (gu32*)(args.ws + WS_CTL);
#pragma unroll
    for (int i = 0; i < 14; ++i) F.in[i] = args.in[i];
    for (int u = F.tid; u < (LDS_BYTES - LDSCTL_OFF) / 4; u += NWAVES * 64) ((LAS unsigned*)(F.lds + LDSCTL_OFF))[u] = 0u;
    __syncthreads();
#if MK_PER_PHASE
#define GRID_BAR() do { } while (0)
#else
    XcdBarrier bar = xcd_barrier_post((unsigned*)(F.ctl + CW_BAR), F.MISC + 8);
#define GRID_BAR() xcd_barrier(bar)
#endif
    const int lo = args.ph_lo, hi = args.ph_hi;
#define IN(k) (lo <= (k) && (k) < hi)
#define BOTH(k) (IN(k) && IN((k) + 1))
    bf16* const WA = (bf16*)(F.ws + WS_WA); bf16* const WAo = (bf16*)(F.ws + WS_WA + 24 * MiB);
    bf16* const ACT = (bf16*)(F.ws + WS_ACT); bf16* const Y = (bf16*)(F.ws + WS_Y); bf16* const PROJ = (bf16*)(F.ws + WS_PROJ); bf16* const HB = (bf16*)(F.ws + WS_H);
    float* const SS = (float*)(F.ws + WS_CTL + SS_OFF);
    const float* const x = F.in[0]; const float* const g_mix = F.in[1]; const float* const g_mlp = F.in[2];

    if (IN(0)) { p0_prologue(F); if (BOTH(0)) GRID_BAR(); }
    if (IN(1)) {
        pg8::Gemm g{ACT, WA, M, NPROJ, D}; pg8::StaticOrder S; S.init(M, NPROJ, F.G, (int)blockIdx.x);
        pg8::EpiBf16S<0> E{PROJ, NPROJ, nullptr};
        pg8::gemm_phase<pg8::EpiBf16S<0>, pg8::StaticOrder, PG8_ALIGN, PG8_SP2>(F.lds + RING_OFF, g, S, E);
        if (BOTH(1)) GRID_BAR();
    }
    if (IN(2)) { gla_gates(F); if (BOTH(2)) GRID_BAR(); }
    if (IN(3)) { gla_recurrence(F); conv_mix(F); if (BOTH(3)) GRID_BAR(); }
    if (IN(4)) { gla_finalize(F); if (BOTH(4)) GRID_BAR(); }
    if (IN(5)) {
        pg8::Gemm g{Y, WAo, M, D, D}; pg8::StaticOrder S; S.init(M, D, F.G, (int)blockIdx.x);
        pg8::EpiResid E{x, F.out, ACT, g_mlp, SS, D};
        pg8::gemm_phase<pg8::EpiResid, pg8::StaticOrder, PG8_ALIGN, PG8_SP2>(F.lds + RING_OFF, g, S, E);
        if (BOTH(5)) GRID_BAR();
    }
    if (IN(6)) {
        transpose_all(F, F.in[10], D, NPROJ, NPROJ, WA);
        transpose_all(F, F.in[11], D, D, D, WAo);
        __syncthreads();
        pg8::Gemm g{ACT, (bf16*)(F.ws + WS_WB), M, FF, D}; pg8::StaticOrder S; S.init(M, FF, F.G, (int)blockIdx.x);
        pg8::EpiBf16S<1> E{HB, FF, SS};
        pg8::gemm_phase<pg8::EpiBf16S<1>, pg8::StaticOrder, PG8_ALIGN, PG8_SP2>(F.lds + RING_OFF, g, S, E);
        if (BOTH(6)) GRID_BAR();
    }
    if (IN(7)) {
        pg8::Gemm g{HB, (bf16*)(F.ws + WS_WB + 32 * MiB), M, D, FF}; pg8::StaticOrder S; S.init(M, D, F.G, (int)blockIdx.x);
        pg8::EpiResid E{F.out, F.out, ACT, g_mix + D, SS + M, D};
        pg8::gemm_phase<pg8::EpiResid, pg8::StaticOrder, PG8_ALIGN, PG8_SP2>(F.lds + RING_OFF, g, S, E);
        if (BOTH(7)) GRID_BAR();
    }
    if (IN(8)) {
        pg8::Gemm g{ACT, WA, M, NPROJ, D}; pg8::StaticOrder S; S.init(M, NPROJ, F.G, (int)blockIdx.x);
        pg8::EpiBf16S<0> E{PROJ, NPROJ, SS + M};
        pg8::gemm_phase<pg8::EpiBf16S<0>, pg8::StaticOrder, PG8_ALIGN, PG8_SP2>(F.lds + RING_OFF, g, S, E);
        if (BOTH(8)) GRID_BAR();
    }
    if (IN(9)) { attn_naive(F); if (BOTH(9)) GRID_BAR(); }
    if (IN(10)) {
        pg8::Gemm g{Y, WAo, M, D, D}; pg8::StaticOrder S; S.init(M, D, F.G, (int)blockIdx.x);
        pg8::EpiResid E{F.out, F.out, ACT, g_mlp + D, SS + 2 * M, D};
        pg8::gemm_phase<pg8::EpiResid, pg8::StaticOrder, PG8_ALIGN, PG8_SP2>(F.lds + RING_OFF, g, S, E);
        if (BOTH(10)) GRID_BAR();
    }
    if (IN(11)) {
        pg8::Gemm g{ACT, (bf16*)(F.ws + WS_WC), M, FF, D}; pg8::StaticOrder S; S.init(M, FF, F.G, (int)blockIdx.x);
        pg8::EpiBf16S<1> E{HB, FF, SS + 2 * M};
        pg8::gemm_phase<pg8::EpiBf16S<1>, pg8::StaticOrder, PG8_ALIGN, PG8_SP2>(F.lds + RING_OFF, g, S, E);
        if (BOTH(11)) GRID_BAR();
    }
    if (IN(12)) {
        pg8::Gemm g{HB, (bf16*)(F.ws + WS_WC + 32 * MiB), M, D, FF}; pg8::StaticOrder S; S.init(M, D, F.G, (int)blockIdx.x);
        pg8::EpiResid E{F.out, F.out, nullptr, nullptr, nullptr, D};
        pg8::gemm_phase<pg8::EpiResid, pg8::StaticOrder, PG8_ALIGN, PG8_SP2>(F.lds + RING_OFF, g, S, E);
        if (BOTH(12)) GRID_BAR();
    }
    if (IN(13)) { final_norm(F); }
#undef IN
#undef BOTH
}

extern "C" void kernel_launch(void* const* d_in, const int* in_sizes, int n_in, void* d_out, int out_size, void* d_ws, size_t ws_size, hipStream_t stream) {
    static int grid = 0;
    if (grid == 0) {
        if (n_in != 14 || in_sizes[0] != M * D || out_size != M * D || ws_size < WS_END) { fprintf(stderr, "kernel_launch: unexpected shapes (n_in %d, in0 %d, out %d, ws %zu); nothing launched\n", n_in, n_in > 0 ? in_sizes[0] : -1, out_size, ws_size); grid = -1; return; }
        int dev = 0, cus = 0, per_cu = 0;
        if (hipGetDevice(&dev) != hipSuccess || hipDeviceGetAttribute(&cus, hipDeviceAttributeMultiprocessorCount, dev) != hipSuccess) { grid = -1; return; }
        if (hipFuncSetAttribute((const void*)mk_fwd, hipFuncAttributeMaxDynamicSharedMemorySize, LDS_BYTES) != hipSuccess) { fprintf(stderr, "kernel_launch: hipFuncSetAttribute failed\n"); grid = -1; return; }
        if (hipOccupancyMaxActiveBlocksPerMultiprocessor(&per_cu, (const void*)mk_fwd, NWAVES * 64, LDS_BYTES) != hipSuccess || per_cu < 1) { fprintf(stderr, "kernel_launch: occupancy query says %d\n", per_cu); }
        (void)hipGetLastError();
        grid = cus;
    }
    if (grid < 0) return;
    if (hipMemsetAsync((char*)d_ws + WS_CTL, 0, CTL_ZERO_BYTES, stream) != hipSuccess) return;
    Args a{};
    for (int i = 0; i < 14; ++i) a.in[i] = (const float*)d_in[i];
    a.out = (float*)d_out; a.ws = (unsigned char*)d_ws;
#if MK_PER_PHASE
    for (int p = 0; p < NPHASE; ++p) { a.ph_lo = p; a.ph_hi = p + 1; hipLaunchKernelGGL(mk_fwd, dim3(grid), dim3(NWAVES * 64), LDS_BYTES, stream, a); }
#else
    a.ph_lo = 0; a.ph_hi = NPHASE; hipLaunchKernelGGL(mk_fwd, dim3(grid), dim3(NWAVES * 64), LDS_BYTES, stream, a);
#endif
}
```

```cpp
#include <hip/hip_runtime.h>
#include <cstdio>
#include <cstdint>
#include <cmath>
namespace pg8 {
#define PG8_LAS __attribute__((address_space(3)))
typedef unsigned short bf16_t;
typedef short bf16x8 __attribute__((ext_vector_type(8)));
typedef float f32x4 __attribute__((ext_vector_type(4)));
typedef unsigned u32x4 __attribute__((ext_vector_type(4)));
typedef int i32x4 __attribute__((ext_vector_type(4)));
__device__ __forceinline__ int fresh_lane() { unsigned z = 0u; asm volatile("" : "+s"(z)); return (int)__builtin_amdgcn_mbcnt_hi(~0u, __builtin_amdgcn_mbcnt_lo(~0u, z)); }
constexpr int BM = 256, BK = 64, HALF = 128, HTB = HALF * BK * 2  , STAGE_BYTES = 8 * HTB, NXCD = 8, WGM = 8;

__host__ __device__ __forceinline__ int lds_byte(int r, int c) { const int st = (r >> 4) * 2 + (c >> 5), rr = r & 15, cc = c & 31, ob = rr * 64 + cc * 2; return st * 1024 + (ob ^ (((ob >> 9) & 1) << 5)); }
__host__ __device__ __forceinline__ void stage_rc(int b, int& R, int& C) { const int st = b / 1024, sb = b % 1024, swz = sb ^ (((sb >> 9) & 1) << 5); R = (st >> 1) * 16 + swz / 64; C = (st & 1) * 32 + (swz % 64) / 2; }
__host__ __device__ __forceinline__ int perm32(int rho) { const int n = rho >> 4, i = rho & 15; return 8 * (i >> 2) + 4 * n + (i & 3); }

struct Unit { int pm, pn; };
struct Gemm { const bf16_t* A; const bf16_t* Bt; int M, N, K; };

struct StaticOrder {
    int nM, nN, nwg, G, c, wgm, revn;
    __host__ __device__ void init(int M, int N, int G_, int c_, int wgm_ = WGM, int revn_ = 0) { nM = M / BM; nN = N / BM; nwg = nM * nN; G = G_; c = c_; wgm = wgm_; revn = revn_; }
    __host__ __device__ bool next(int i, Unit& u) const {
        const long L = (long)i * G + c; if (L >= nwg) return false;
        int wgid = (int)L; { const int q = nwg / NXCD, r = nwg % NXCD, xcd = wgid % NXCD, off = wgid / NXCD; wgid = (xcd < r ? xcd * (q + 1) : r * (q + 1) + (xcd - r) * q) + off; }
        const int nig = wgm * nN, gid = wgid / nig, fm = gid * wgm, gsz = (nM - fm) < wgm ? (nM - fm) : wgm;
        u.pm = fm + ((wgid % nig) % gsz); u.pn = (wgid % nig) / gsz; if (revn) u.pn = nN - 1 - u.pn; return true;
    }
    __device__ __forceinline__ void a_ready(const Unit&) const {}
    __device__ __forceinline__ void done(const Unit&) const {}
};
__device__ __forceinline__ unsigned cvt_pk_bf16(float lo, float hi) { unsigned r; asm volatile("v_cvt_pk_bf16_f32 %0, %1, %2" : "=v"(r) : "v"(lo), "v"(hi)); return r; }
typedef unsigned u32x2 __attribute__((ext_vector_type(2)));
constexpr float RMS_EPS = 1e-6f, INV_D = 1.0f / 2048.0f;

template <int MODE> struct EpiBf16S {
    static constexpr bool PERM = true, AFTER_DRAIN = false;
    bf16_t* O; int ldc; const unsigned long long* ss; float mul = 1.0f;
    __device__ __forceinline__ void operator()(const f32x4 (&acc)[2][2][4][2], const Unit& u, int wr, int wc, int fr, int fq) const {
        const int row0 = u.pm * BM + wr * 64 + fr, col0 = u.pn * BM + wc * 32 + 8 * fq;
#pragma unroll
        for (int ai = 0; ai < 2; ++ai)
#pragma unroll
            for (int m = 0; m < 4; ++m) { const int row = row0 + ai * HALF + m * 16; bf16_t* rowp = O + (size_t)row * ldc + col0;
                float sc = mul; if (ss) sc = mul * __builtin_amdgcn_rsqf((float)ss[row] * (INV_D / 1048576.0f) + RMS_EPS);
#pragma unroll
                for (int bj = 0; bj < 2; ++bj) { f32x4 v0 = acc[ai][bj][m][0], v1 = acc[ai][bj][m][1];
                    if (MODE == 1) {
#pragma unroll
                        for (int j = 0; j < 4; ++j) { float a = fmaxf(v0[j], 0.f) * sc, b = fmaxf(v1[j], 0.f) * sc; v0[j] = a * a; v1[j] = b * b; } }
                    else { v0 = v0 * sc; v1 = v1 * sc; }
                    u32x4 w; w.x = cvt_pk_bf16(v0[0], v0[1]); w.y = cvt_pk_bf16(v0[2], v0[3]); w.z = cvt_pk_bf16(v1[0], v1[1]); w.w = cvt_pk_bf16(v1[2], v1[3]);
                    *(u32x4*)(rowp + bj * HALF) = w; } }
    }
};
struct EpiProj0 {
    static constexpr bool PERM = true, AFTER_DRAIN = false;
    bf16_t* O; int ldc;
    __device__ __forceinline__ void operator()(const f32x4 (&acc)[2][2][4][2], const Unit& u, int wr, int wc, int fr, int fq) const {
        const int row0 = u.pm * BM + wr * 64 + fr; const bool prod = (u.pn >= 4) && (u.pn < 12);
        const int col0 = prod ? (1024 + (u.pn - 4) * HALF + wc * 32 + 8 * fq) : (u.pn * BM + wc * 32 + 8 * fq);
#pragma unroll
        for (int ai = 0; ai < 2; ++ai)
#pragma unroll
            for (int m = 0; m < 4; ++m) { bf16_t* rowp = O + (size_t)(row0 + ai * HALF + m * 16) * ldc + col0;
                if (prod) { const f32x4 v0 = acc[ai][0][m][0] * acc[ai][1][m][0], v1 = acc[ai][0][m][1] * acc[ai][1][m][1];
                    u32x4 w; w.x = cvt_pk_bf16(v0[0], v0[1]); w.y = cvt_pk_bf16(v0[2], v0[3]); w.z = cvt_pk_bf16(v1[0], v1[1]); w.w = cvt_pk_bf16(v1[2], v1[3]);
                    *(u32x4*)rowp = w; }
                else {
#pragma unroll
                    for (int bj = 0; bj < 2; ++bj) { const f32x4 v0 = acc[ai][bj][m][0], v1 = acc[ai][bj][m][1];
                        u32x4 w; w.x = cvt_pk_bf16(v0[0], v0[1]); w.y = cvt_pk_bf16(v0[2], v0[3]); w.z = cvt_pk_bf16(v1[0], v1[1]); w.w = cvt_pk_bf16(v1[2], v1[3]);
                        *(u32x4*)(rowp + bj * HALF) = w; } } }
    }
};
__device__ __forceinline__ unsigned pk4_fp8(float a, float b, float c, float d) { int w = __builtin_amdgcn_cvt_pk_fp8_f32(a, b, 0, false); w = __builtin_amdgcn_cvt_pk_fp8_f32(c, d, w, true); return (unsigned)w; }
constexpr float Q8_CLIP = 4.6f;
__device__ __forceinline__ float rowq_inv(unsigned long long ssv, float clip) { return clip * (1.0f / 127.0f) * __builtin_sqrtf((float)ssv * (INV_D / 1048576.0f) + RMS_EPS); }
__device__ __forceinline__ unsigned qbyte(float x) { const float t = __builtin_fmaxf(__builtin_fminf(x, 127.f), -127.f); return __builtin_bit_cast(unsigned, t + 12582912.f); }
__device__ __forceinline__ unsigned pk4_i8(float a, float b, float c, float d) { return (qbyte(a) & 0xffu) | ((qbyte(b) & 0xffu) << 8) | ((qbyte(c) & 0xffu) << 16) | (qbyte(d) << 24); }
template <bool BASE_F32, int W8 = 0> struct EpiRes2 {
    static constexpr bool PERM = true, AFTER_DRAIN = false;
    const void* base; bf16_t* O; unsigned long long* ss; int ldc; unsigned char* O8 = nullptr; const unsigned long long* qs = nullptr; float qclip = Q8_CLIP;
    __device__ __forceinline__ void operator()(const f32x4 (&acc)[2][2][4][2], const Unit& u, int wr, int wc, int fr, int fq) const {
        const int row0 = u.pm * BM + wr * 64 + fr, col0 = u.pn * BM + wc * 32 + 8 * fq;
        float sv[8];
#pragma unroll
        for (int ai = 0; ai < 2; ++ai)
#pragma unroll
            for (int m = 0; m < 4; ++m) { const int row = row0 + ai * HALF + m * 16; const size_t off = (size_t)row * ldc + col0; float s = 0.f;
                float sq = 0.f; if constexpr (W8 == 2) sq = __builtin_amdgcn_rcpf(rowq_inv(qs[row], qclip));
#pragma unroll
                for (int bj = 0; bj < 2; ++bj) { f32x4 v0 = acc[ai][bj][m][0], v1 = acc[ai][bj][m][1];
                    if (BASE_F32) { const float* bp = (const float*)base + off + bj * HALF; v0 = v0 + *(const f32x4*)bp; v1 = v1 + *(const f32x4*)(bp + 4); }
                    else { const u32x4 b = *(const u32x4*)((const bf16_t*)base + off + bj * HALF);
                        v0[0] += __uint_as_float(b.x << 16); v0[1] += __uint_as_float(b.x & 0xffff0000u); v0[2] += __uint_as_float(b.y << 16); v0[3] += __uint_as_float(b.y & 0xffff0000u);
                        v1[0] += __uint_as_float(b.z << 16); v1[1] += __uint_as_float(b.z & 0xffff0000u); v1[2] += __uint_as_float(b.w << 16); v1[3] += __uint_as_float(b.w & 0xffff0000u); }
                    s += ((v0[0] * v0[0] + v0[1] * v0[1]) + (v0[2] * v0[2] + v0[3] * v0[3])) + ((v1[0] * v1[0] + v1[1] * v1[1]) + (v1[2] * v1[2] + v1[3] * v1[3]));
                    u32x4 w; w.x = cvt_pk_bf16(v0[0], v0[1]); w.y = cvt_pk_bf16(v0[2], v0[3]); w.z = cvt_pk_bf16(v1[0], v1[1]); w.w = cvt_pk_bf16(v1[2], v1[3]);
                    *(u32x4*)(O + off + bj * HALF) = w;
                    if constexpr (W8 == 1) { u32x2 w8; w8.x = pk4_fp8(v0[0], v0[1], v0[2], v0[3]); w8.y = pk4_fp8(v1[0], v1[1], v1[2], v1[3]); *(u32x2*)(O8 + off + bj * HALF) = w8; }
                    if constexpr (W8 == 2) { u32x2 w8; w8.x = pk4_i8(v0[0] * sq, v0[1] * sq, v0[2] * sq, v0[3] * sq); w8.y = pk4_i8(v1[0] * sq, v1[1] * sq, v1[2] * sq, v1[3] * sq); *(u32x2*)(O8 + off + bj * HALF) = w8; } }
                s += __shfl_xor(s, 16); s += __shfl_xor(s, 32); sv[ai * 4 + m] = s;
                asm volatile("" ::: "memory"); }
        if (ss) {
#pragma unroll
            for (int hh = 0; hh < 2; ++hh) { float v = sv[4 * hh];
#pragma unroll
                for (int q = 1; q < 4; ++q) v = (fq == q) ? sv[4 * hh + q] : v;
                atomicAdd(ss + row0 + hh * HALF + fq * 16, (unsigned long long)(v * 1048576.0f + 0.5f)); } }
    }
};

template <int MODE> struct EpiI8 {
    static constexpr bool PERM = true, AFTER_DRAIN = false;
    bf16_t* O; int ldc; const unsigned long long* ssn; const unsigned long long* ssq; const unsigned* cmax; float qclip = Q8_CLIP;
    __device__ __forceinline__ void operator()(const f32x4 (&acc)[2][2][4][2], const Unit& u, int wr, int wc, int fr, int fq) const {
        const int row0 = u.pm * BM + wr * 64 + fr, col0 = u.pn * BM + wc * 32 + 8 * fq;
        f32x4 cf[2][2];
#pragma unroll
        for (int bj = 0; bj < 2; ++bj)
#pragma unroll
            for (int n = 0; n < 2; ++n) { const u32x4 c = *(const u32x4*)(cmax + col0 + bj * HALF + 4 * n);
                cf[bj][n] = (f32x4){__uint_as_float(c.x), __uint_as_float(c.y), __uint_as_float(c.z), __uint_as_float(c.w)} * (1.0f / 127.0f); }
#pragma unroll
        for (int ai = 0; ai < 2; ++ai)
#pragma unroll
            for (int m = 0; m < 4; ++m) { const int row = row0 + ai * HALF + m * 16; bf16_t* rowp = O + (size_t)row * ldc + col0;
                const float rf = __builtin_amdgcn_rsqf((float)ssn[row] * (INV_D / 1048576.0f) + RMS_EPS) * rowq_inv(ssq[row], qclip);
#pragma unroll
                for (int bj = 0; bj < 2; ++bj) { const i32x4 a0 = __builtin_bit_cast(i32x4, acc[ai][bj][m][0]), a1 = __builtin_bit_cast(i32x4, acc[ai][bj][m][1]); f32x4 v0, v1;
#pragma unroll
                    for (int j = 0; j < 4; ++j) { if (MODE == 1) { const float x = fmaxf((float)a0[j] * cf[bj][0][j], 0.f) * rf, y = fmaxf((float)a1[j] * cf[bj][1][j], 0.f) * rf; v0[j] = x * x; v1[j] = y * y; }
                        else { v0[j] = (float)a0[j] * cf[bj][0][j] * rf; v1[j] = (float)a1[j] * cf[bj][1][j] * rf; } }
                    u32x4 w; w.x = cvt_pk_bf16(v0[0], v0[1]); w.y = cvt_pk_bf16(v0[2], v0[3]); w.z = cvt_pk_bf16(v1[0], v1[1]); w.w = cvt_pk_bf16(v1[2], v1[3]);
                    *(u32x4*)(rowp + bj * HALF) = w; } }
    }
};

struct EpiQkvI8 {
    static constexpr bool PERM = true, AFTER_DRAIN = false;
    unsigned char* QKV; const unsigned long long* ssn; const unsigned long long* ssq; const unsigned* cmax; float qclip = Q8_CLIP;
    __device__ __forceinline__ void operator()(const f32x4 (&acc)[2][2][4][2], const Unit& u, int wr, int wc, int fr, int fq) const {
        const int row0 = u.pm * BM + wr * 64 + fr, col0 = u.pn * BM + wc * 32 + 8 * fq;
        f32x4 cf[2][2];
#pragma unroll
        for (int bj = 0; bj < 2; ++bj)
#pragma unroll
            for (int n = 0; n < 2; ++n) { const u32x4 c = *(const u32x4*)(cmax + col0 + bj * HALF + 4 * n);
                cf[bj][n] = (f32x4){__uint_as_float(c.x), __uint_as_float(c.y), __uint_as_float(c.z), __uint_as_float(c.w)} * (1.0f / 127.0f); }
#pragma unroll
        for (int ai = 0; ai < 2; ++ai)
#pragma unroll
            for (int m = 0; m < 4; ++m) { const int row = row0 + ai * HALF + m * 16;
                const float rf = __builtin_amdgcn_rsqf((float)ssn[row] * (INV_D / 1048576.0f) + RMS_EPS) * rowq_inv(ssq[row], qclip);
#pragma unroll
                for (int bj = 0; bj < 2; ++bj) { const i32x4 a0 = __builtin_bit_cast(i32x4, acc[ai][bj][m][0]), a1 = __builtin_bit_cast(i32x4, acc[ai][bj][m][1]); f32x4 v0, v1;
#pragma unroll
                    for (int j = 0; j < 4; ++j) { v0[j] = (float)a0[j] * cf[bj][0][j] * rf; v1[j] = (float)a1[j] * cf[bj][1][j] * rf; }
                    u32x2 w8; w8.x = pk4_fp8(v0[0], v0[1], v0[2], v0[3]); w8.y = pk4_fp8(v1[0], v1[1], v1[2], v1[3]);
                    *(u32x2*)(QKV + (size_t)row * 6144 + col0 + bj * HALF) = w8; } }
    }
};

struct EpiFinal {
    static constexpr bool PERM = true, AFTER_DRAIN = false;
    const bf16_t* base; float* out; const float* g; unsigned long long* ss; unsigned* cnt; int ldc;
    __device__ __forceinline__ void operator()(f32x4 (&acc)[2][2][4][2], const Unit& u, int wr, int wc, int fr, int fq) const {
        const int row0 = u.pm * BM + wr * 64 + fr, col0 = u.pn * BM + wc * 32 + 8 * fq;
        float sv[8];
#pragma unroll
        for (int ai = 0; ai < 2; ++ai)
#pragma unroll
            for (int m = 0; m < 4; ++m) { const int row = row0 + ai * HALF + m * 16; const size_t off = (size_t)row * ldc + col0; float s = 0.f;
#pragma unroll
                for (int bj = 0; bj < 2; ++bj) { f32x4 v0 = acc[ai][bj][m][0], v1 = acc[ai][bj][m][1];
                    const u32x4 b = *(const u32x4*)(base + off + bj * HALF);
                    v0[0] += __uint_as_float(b.x << 16); v0[1] += __uint_as_float(b.x & 0xffff0000u); v0[2] += __uint_as_float(b.y << 16); v0[3] += __uint_as_float(b.y & 0xffff0000u);
                    v1[0] += __uint_as_float(b.z << 16); v1[1] += __uint_as_float(b.z & 0xffff0000u); v1[2] += __uint_as_float(b.w << 16); v1[3] += __uint_as_float(b.w & 0xffff0000u);
                    s += ((v0[0] * v0[0] + v0[1] * v0[1]) + (v0[2] * v0[2] + v0[3] * v0[3])) + ((v1[0] * v1[0] + v1[1] * v1[1]) + (v1[2] * v1[2] + v1[3] * v1[3]));
                    acc[ai][bj][m][0] = v0; acc[ai][bj][m][1] = v1; }
                s += __shfl_xor(s, 16); s += __shfl_xor(s, 32); sv[ai * 4 + m] = s; }
#pragma unroll
        for (int hh = 0; hh < 2; ++hh) { float v = sv[4 * hh];
#pragma unroll
            for (int q = 1; q < 4; ++q) v = (fq == q) ? sv[4 * hh + q] : v;
            atomicAdd(ss + row0 + hh * HALF + fq * 16, (unsigned long long)(v * 1048576.0f + 0.5f)); }
        asm volatile("s_waitcnt vmcnt(0)" ::: "memory");
        unsigned* c = cnt + 64 * u.pm;
        if ((fr | fq) == 0) __hip_atomic_fetch_add(c, 1u, __ATOMIC_RELAXED, __HIP_MEMORY_SCOPE_AGENT);
        { unsigned spins = 0; const unsigned want = 64u;
          while ((unsigned)__builtin_amdgcn_readfirstlane(__hip_atomic_load(c, __ATOMIC_RELAXED, __HIP_MEMORY_SCOPE_AGENT)) < want) { __builtin_amdgcn_s_sleep(2); if (++spins > (1u << 22)) break; } }
        f32x4 gv[2][2];
#pragma unroll
        for (int bj = 0; bj < 2; ++bj) { gv[bj][0] = *(const f32x4*)(g + col0 + bj * HALF); gv[bj][1] = *(const f32x4*)(g + col0 + bj * HALF + 4); }
#pragma unroll
        for (int ai = 0; ai < 2; ++ai)
#pragma unroll
            for (int m = 0; m < 4; ++m) { const int row = row0 + ai * HALF + m * 16; const size_t off = (size_t)row * ldc + col0;
                const unsigned long long sq = __hip_atomic_load(ss + row, __ATOMIC_RELAXED, __HIP_MEMORY_SCOPE_AGENT);
                const float sc = __builtin_amdgcn_rsqf((float)sq * (INV_D / 1048576.0f) + RMS_EPS);
#pragma unroll
                for (int bj = 0; bj < 2; ++bj) { *(f32x4*)(out + off + bj * HALF) = acc[ai][bj][m][0] * gv[bj][0] * sc; *(f32x4*)(out + off + bj * HALF + 4) = acc[ai][bj][m][1] * gv[bj][1] * sc; } }
    }
};

template <class Epi, class Sched, bool ALIGN_EPI = false, bool SP2 = false, int NUM = 0>
__device__ __forceinline__ void gemm_phase(PG8_LAS unsigned char* lds, const Gemm g, const Sched& S, const Epi& E, const int wid  ) {
    constexpr bool F8 = (NUM == 1), I8 = (NUM == 2);
    const int lane = fresh_lane(), tid = wid * 64 + lane, wr = wid >> 2, wc = wid & 3, fr = lane & 15, fq = lane >> 4;
    const int K = (NUM != 0) ? g.K / 2 : g.K, nt = K / BK;
    unsigned voffA[2], voffB[2];
#pragma unroll
    for (int i = 0; i < 2; ++i) { int R, C; stage_rc(tid * 16 + i * 8192, R, C); const int Rb = Epi::PERM ? ((R & ~31) + perm32(R & 31)) : R;
        voffA[i] = (unsigned)(R * K + C) * 2u; voffB[i] = (unsigned)(Rb * K + C) * 2u; }
    const size_t kstep = (size_t)(BK * 2);
    const size_t hstep = (size_t)HALF * K * 2;
    const size_t tstep = 2 * hstep;
    const unsigned ldsw = (unsigned)wid * 1024u;
    const int aoff = lds_byte(wr * 64 + fr, fq * 8), boff = lds_byte(wc * 32 + fr, fq * 8);
#define PG8_SA(b, h) (((b) * 2 + (h)) * HTB)
#define PG8_SB(b, h) ((4 + (b) * 2 + (h)) * HTB)
#define PG8_STAGE(bufoff, gbase, voff) do { _Pragma("unroll") for (int _i = 0; _i < 2; ++_i) { unsigned _vo = (voff)[_i]; asm volatile("" : "+v"(_vo)); \
        __builtin_amdgcn_global_load_lds((const unsigned*)((const char*)(gbase) + _vo), (PG8_LAS unsigned*)(lds + (bufoff) + ldsw + _i * 8192), 16, 0, 0); } } while (0)
#define PG8_LDA(dst, b, h) do { _Pragma("unroll") for (int m = 0; m < 4; ++m) _Pragma("unroll") for (int k = 0; k < 2; ++k) dst[m][k] = *(const PG8_LAS bf16x8*)(lds + PG8_SA(b, h) + aoff + m * 2048 + k * 1024); } while (0)
#define PG8_LDB(dst, b, h) do { _Pragma("unroll") for (int n = 0; n < 2; ++n) _Pragma("unroll") for (int k = 0; k < 2; ++k) dst[n][k] = *(const PG8_LAS bf16x8*)(lds + PG8_SB(b, h) + boff + n * 2048 + k * 1024); } while (0)
#define PG8_CAT8(x) __builtin_shufflevector(__builtin_bit_cast(i32x4, (x)[0]), __builtin_bit_cast(i32x4, (x)[1]), 0, 1, 2, 3, 4, 5, 6, 7)
#define PG8_MMA(ai, bj, At, Bt) do { __builtin_amdgcn_s_setprio(1); _Pragma("unroll") for (int m = 0; m < 4; ++m) _Pragma("unroll") for (int n = 0; n < 2; ++n) { \
        if constexpr (F8) acc[ai][bj][m][n] = __builtin_amdgcn_mfma_scale_f32_16x16x128_f8f6f4(PG8_CAT8(Bt[n]), PG8_CAT8(At[m]), acc[ai][bj][m][n], 0, 0, 0, 0, 0, 0); \
        else if constexpr (I8) { _Pragma("unroll") for (int k = 0; k < 2; ++k) acc[ai][bj][m][n] = __builtin_bit_cast(f32x4, __builtin_amdgcn_mfma_i32_16x16x64_i8(__builtin_bit_cast(i32x4, Bt[n][k]), __builtin_bit_cast(i32x4, At[m][k]), __builtin_bit_cast(i32x4, acc[ai][bj][m][n]), 0, 0, 0)); } \
        else { _Pragma("unroll") for (int k = 0; k < 2; ++k) acc[ai][bj][m][n] = __builtin_amdgcn_mfma_f32_16x16x32_bf16(Bt[n][k], At[m][k], acc[ai][bj][m][n], 0, 0, 0); } } __builtin_amdgcn_s_setprio(0); } while (0)
#define PG8_WAIT_V(n) asm volatile("s_waitcnt vmcnt(" #n ")" ::: "memory")
#define PG8_WAIT_L(n) asm volatile("s_waitcnt lgkmcnt(" #n ")" ::: "memory")
#define PG8_BAR __builtin_amdgcn_s_barrier()
#define PG8_SCHED __builtin_amdgcn_sched_barrier(0)
    Unit cur, nxt; int ui = 0;
    if (!S.next(0, cur)) return;
    f32x4 acc[2][2][4][2];
#pragma unroll
    for (int a = 0; a < 2; ++a)
#pragma unroll
        for (int b = 0; b < 2; ++b)
#pragma unroll
            for (int m = 0; m < 4; ++m)
#pragma unroll
                for (int n = 0; n < 2; ++n) acc[a][b][m][n] = (f32x4){0.f, 0.f, 0.f, 0.f};
    bf16x8 At[4][2], B0[2][2], B1[2][2];
    const char* cA = (const char*)g.A + (size_t)cur.pm * tstep; const char* cB = (const char*)g.Bt + (size_t)cur.pn * tstep;
    S.a_ready(cur);
    if constexpr (SP2) {
        PG8_STAGE(PG8_SB(0, 0), cB, voffB); PG8_STAGE(PG8_SB(0, 1), cB + hstep, voffB); PG8_STAGE(PG8_SA(0, 0), cA, voffA); PG8_STAGE(PG8_SA(0, 1), cA + hstep, voffA);
        if (wr == 1) PG8_BAR;
        PG8_WAIT_V(2); PG8_BAR;
        PG8_STAGE(PG8_SB(1, 0), cB + kstep, voffB); PG8_STAGE(PG8_SA(1, 0), cA + kstep, voffA); PG8_STAGE(PG8_SB(1, 1), cB + hstep + kstep, voffB);
        PG8_WAIT_V(6); PG8_BAR;
    } else {
        PG8_STAGE(PG8_SB(0, 0), cB, voffB); PG8_STAGE(PG8_SA(0, 0), cA, voffA); PG8_STAGE(PG8_SB(0, 1), cB + hstep, voffB); PG8_STAGE(PG8_SA(0, 1), cA + hstep, voffA);
        if (wr == 1) PG8_BAR;
        PG8_WAIT_V(4); PG8_BAR;
        PG8_STAGE(PG8_SB(1, 0), cB + kstep, voffB); PG8_STAGE(PG8_SA(1, 0), cA + kstep, voffA); PG8_STAGE(PG8_SB(1, 1), cB + hstep + kstep, voffB);
        PG8_WAIT_V(6); PG8_BAR;
    }
    for (;;) {
        const bool has_next = S.next(ui + 1, nxt);
        const char* nA = has_next ? (const char*)g.A + (size_t)nxt.pm * tstep : cA; const char* nB = has_next ? (const char*)g.Bt + (size_t)nxt.pn * tstep : cB;
        for (int t = 0; t < nt; t += 2) {
            const bool last = (t == nt - 2);
            const char* a1 = cA + (size_t)(t + 1) * kstep;
            const char* a2 = last ? nA : cA + (size_t)(t + 2) * kstep; const char* b2 = last ? nB : cB + (size_t)(t + 2) * kstep;
            const char* a3 = a2 + kstep; const char* b3 = b2 + kstep;
            if (last && has_next) S.a_ready(nxt);
            if constexpr (SP2) {
            PG8_LDB(B0, 0, 0); PG8_LDB(B1, 0, 1); PG8_SCHED; PG8_LDA(At, 0, 0); PG8_STAGE(PG8_SA(1, 1), a1 + hstep, voffA);
            PG8_WAIT_V(8); PG8_WAIT_L(0); PG8_BAR; PG8_MMA(0, 0, At, B0); PG8_MMA(0, 1, At, B1); PG8_BAR; PG8_SCHED;
            PG8_LDA(At, 0, 1); PG8_STAGE(PG8_SB(0, 0), b2, voffB); PG8_STAGE(PG8_SB(0, 1), b2 + hstep, voffB); PG8_STAGE(PG8_SA(0, 0), a2, voffA);
            PG8_WAIT_V(8); PG8_WAIT_L(0); PG8_BAR; PG8_MMA(1, 0, At, B0); PG8_MMA(1, 1, At, B1); PG8_BAR; PG8_SCHED;
            PG8_LDB(B0, 1, 0); PG8_LDB(B1, 1, 1); PG8_SCHED; PG8_LDA(At, 1, 0); PG8_STAGE(PG8_SA(0, 1), a2 + hstep, voffA);
            PG8_WAIT_V(8); PG8_WAIT_L(0); PG8_BAR; PG8_MMA(0, 0, At, B0); PG8_MMA(0, 1, At, B1); PG8_BAR; PG8_SCHED;
            PG8_LDA(At, 1, 1); PG8_STAGE(PG8_SB(1, 0), b3, voffB); PG8_STAGE(PG8_SB(1, 1), b3 + hstep, voffB); PG8_STAGE(PG8_SA(1, 0), a3, voffA);
            PG8_WAIT_V(8); PG8_WAIT_L(0); PG8_BAR; PG8_MMA(1, 0, At, B0); PG8_MMA(1, 1, At, B1); PG8_BAR; PG8_SCHED;
            } else {
            PG8_LDB(B0, 0, 0); PG8_SCHED; PG8_LDA(At, 0, 0); PG8_STAGE(PG8_SA(1, 1), a1 + hstep, voffA);
            PG8_WAIT_L(8); PG8_BAR; PG8_WAIT_L(0); PG8_MMA(0, 0, At, B0); PG8_BAR; PG8_SCHED;
            PG8_LDB(B1, 0, 1); PG8_STAGE(PG8_SB(0, 0), b2, voffB);
            PG8_BAR; PG8_WAIT_L(0); PG8_MMA(0, 1, At, B1); PG8_BAR;
            PG8_LDA(At, 0, 1); PG8_STAGE(PG8_SA(0, 0), a2, voffA);
            PG8_BAR; PG8_WAIT_L(0); PG8_MMA(1, 0, At, B0); PG8_BAR; PG8_SCHED;
            PG8_STAGE(PG8_SB(0, 1), b2 + hstep, voffB);
            PG8_WAIT_V(6); PG8_BAR; PG8_MMA(1, 1, At, B1); PG8_BAR;
            PG8_LDB(B0, 1, 0); PG8_SCHED; PG8_LDA(At, 1, 0); PG8_STAGE(PG8_SA(0, 1), a2 + hstep, voffA);
            PG8_WAIT_L(8); PG8_BAR; PG8_WAIT_L(0); PG8_MMA(0, 0, At, B0); PG8_BAR; PG8_SCHED;
            PG8_LDB(B1, 1, 1); PG8_STAGE(PG8_SB(1, 0), b3, voffB);
            PG8_BAR; PG8_WAIT_L(0); PG8_MMA(0, 1, At, B1); PG8_BAR;
            PG8_LDA(At, 1, 1); PG8_STAGE(PG8_SA(1, 0), a3, voffA);
            PG8_BAR; PG8_WAIT_L(0); PG8_MMA(1, 0, At, B0); PG8_BAR; PG8_SCHED;
            PG8_STAGE(PG8_SB(1, 1), b3 + hstep, voffB);
            PG8_WAIT_V(6); PG8_BAR; PG8_MMA(1, 1, At, B1); PG8_BAR;
            }
        }
        if constexpr (ALIGN_EPI) { if (wr == 0) PG8_BAR; }
        if constexpr (!Epi::AFTER_DRAIN) { E(acc, cur, wr, wc, fr, fq); S.done(cur); }
        if (!has_next) break;
#pragma unroll
        for (int a = 0; a < 2; ++a)
#pragma unroll
            for (int b = 0; b < 2; ++b)
#pragma unroll
                for (int m = 0; m < 4; ++m)
#pragma unroll
                    for (int n = 0; n < 2; ++n) acc[a][b][m][n] = (f32x4){0.f, 0.f, 0.f, 0.f};
        cur = nxt; cA = nA; cB = nB; ++ui;
        if constexpr (ALIGN_EPI) { if (wr == 1) PG8_BAR; }
    }
    PG8_WAIT_V(0);
    if constexpr (!ALIGN_EPI) { if (wr == 0) PG8_BAR; }
    PG8_BAR;
    if constexpr (Epi::AFTER_DRAIN) { E.fused(acc, cur, wr, wc, fr, fq, lds, wid, lane); S.done(cur); }
#undef PG8_SA
#undef PG8_SB
#undef PG8_STAGE
#undef PG8_LDA
#undef PG8_LDB
#undef PG8_MMA
#undef PG8_CAT8
#undef PG8_WAIT_V
#undef PG8_WAIT_L
#undef PG8_BAR
#undef PG8_SCHED
}
}
#ifndef PG8_SP2
#define PG8_SP2 true
#endif
#ifndef PG8_ALIGN
#define PG8_ALIGN true
#endif
#ifndef MK_PER_PHASE
#define MK_PER_PHASE 0
#endif
constexpr int NWAVES = 8;
constexpr int BATCH = 4, T = 4096, D = 2048, M = BATCH * T, FF = 8192, NPROJ = 6144, INCOLS = 6160;
constexpr int O_CB = 0, O_CC = 1024, O_CX = 2048, O_Q = 3072, O_K = 3584, O_V = 4096, O_R = 5120, O_GL = 6144;
constexpr float EPS = 1e-6f;
constexpr int NPHASE = 16;

constexpr size_t MiB = 1u << 20;
constexpr size_t WS_CTL = 0, CTL_ZERO_BYTES = 1 * MiB;
constexpr size_t WS_GLOW = 1 * MiB;
constexpr size_t WS_WA = 2 * MiB;
constexpr size_t WS_WB = 34 * MiB;
constexpr size_t WS_WC = 98 * MiB;
constexpr size_t WS_ACT = 162 * MiB;
constexpr size_t WS_Y = 226 * MiB;
constexpr size_t WS_PROJ = 290 * MiB;
constexpr size_t WS_A8 = WS_WB;
constexpr float QKV_WSCALE = 64.0f;
constexpr size_t SSX_OFF = 896 * 1024;
constexpr size_t CMAX0_OFF = 128 * 1024, CMAXQ_OFF = 160 * 1024;
constexpr size_t OUT_W8A = 64 * MiB, OUT_X8A = 80 * MiB, OUT_WQ8 = 0, OUT_WO = 32 * MiB;
constexpr float CLIP_X1 = 4.6f * 1.30f, CLIP_X2 = 4.6f * 1.40f;
constexpr size_t WS_W8 = WS_WB;
constexpr size_t WS_X8 = WS_WB + 32 * MiB;
constexpr size_t CMAX1_OFF = 96 * 1024;
constexpr size_t WS_H = WS_Y;
constexpr size_t WS_END = 482 * MiB;
static_assert(WS_H + (size_t)M * FF * 2 == WS_END && WS_PROJ + (size_t)M * NPROJ * 2 == WS_END, "ws map");
constexpr int CW_BAR = 4096;
constexpr size_t SS_OFF = 256 * 1024;
static_assert(SS_OFF + 4 * (size_t)M * 8 <= 768 * 1024, "ss inside the memset region, below DV");
constexpr size_t FCNT_OFF = 64 * 1024;

constexpr int RING_OFF = 0, RING_BYTES = 131072;
constexpr int LDSCTL_OFF = 140288, MISC_OFF = LDSCTL_OFF + 320;
constexpr int LDS_BYTES = 147456;
static_assert(MISC_OFF + 128 <= LDS_BYTES, "LDS map");

#define GAS __attribute__((address_space(1)))
#define LAS __attribute__((address_space(3)))
typedef unsigned short bf16;
typedef unsigned v4u __attribute__((ext_vector_type(4)));
typedef float f32x4 __attribute__((ext_vector_type(4)));
typedef short bf16x8 __attribute__((ext_vector_type(8)));
typedef GAS unsigned gu32;
typedef GAS unsigned long long gu64;
#define RLX_AGENT __ATOMIC_RELAXED, __HIP_MEMORY_SCOPE_AGENT
#define LDS_WAIT() asm volatile("s_waitcnt lgkmcnt(0)" ::: "memory")
#define VM_WAIT() asm volatile("s_waitcnt vmcnt(0)" ::: "memory")
__device__ __forceinline__ unsigned long long rt() { return __builtin_amdgcn_s_memrealtime(); }
__device__ __forceinline__ unsigned f2bf(float f) { unsigned u = __builtin_bit_cast(unsigned, f); return (u + 0x7fffu + ((u >> 16) & 1u)) >> 16; }
__device__ __forceinline__ unsigned pk2(float lo, float hi) { return f2bf(lo) | (f2bf(hi) << 16); }

#define XB_TMO      128
#define XB_XCNT(j)  (256  + 64 * (j))
#define XB_XSUB(j)  (1280 + 64 * (j))
#define XB_XGEN(j)  (2304 + 64 * (j))
#define XB_TOP      3328
#define XB_TOPGEN   3392
#define XCD_BAR_WORDS 3456
#define XB_SPIN_CAP (1u << 18)

__device__ __forceinline__ unsigned xb_ld(unsigned* p)              { return __hip_atomic_load(p, __ATOMIC_RELAXED, __HIP_MEMORY_SCOPE_AGENT); }
__device__ __forceinline__ unsigned xb_add(unsigned* p, unsigned v) { return __hip_atomic_fetch_add(p, v, __ATOMIC_RELAXED, __HIP_MEMORY_SCOPE_AGENT); }
__device__ __forceinline__ unsigned xb_xcc_id() { return (unsigned)__builtin_amdgcn_s_getreg((3 << 11) | 20) & 0xFu; }
#define XB_SPIN(cond, bar) do { unsigned _sp = 0; while (cond) { __builtin_amdgcn_s_sleep(1); \
    if ((++_sp & 255u) == 0u) { if (xb_ld(&(bar)[XB_TMO])) break; if (_sp > XB_SPIN_CAP) { atomicAdd(&(bar)[XB_TMO], 1u); break; } } } } while (0)

struct XcdBarrier {
    unsigned* bar; unsigned x;
    volatile LAS unsigned* st;
    bool w0;
};

__device__ __forceinline__ XcdBarrier xcd_barrier_post(unsigned* bar, volatile LAS unsigned* st, int wave) {
    XcdBarrier b; b.bar = bar; b.x = xb_xcc_id(); b.st = st; b.w0 = (wave == 0);
    if (b.w0 && pg8::fresh_lane() == 0) (void)xb_add(&bar[XB_XCNT(b.x)], 1u);
    return b;
}
__device__ __forceinline__ void xcd_barrier_complete(unsigned* bar, unsigned x, unsigned& nloc, unsigned& nx) {
    const unsigned G = gridDim.x * gridDim.y * gridDim.z;
    unsigned sum, cnt, mine, sp = 0u;
    for (;;) {
        sum = 0u; cnt = 0u; mine = 0u;
#pragma unroll
        for (unsigned j = 0; j < 16; ++j) { const unsigned c = xb_ld(&bar[XB_XCNT(j)]); sum += c; cnt += (c > 0u) ? 1u : 0u; mine = (j == x) ? c : mine; }
        if (sum == G) break;
        __builtin_amdgcn_s_sleep(1);
        if ((++sp & 255u) == 0u) { if (xb_ld(&bar[XB_TMO])) break; if (sp > XB_SPIN_CAP) { atomicAdd(&bar[XB_TMO], 1u); break; } }
    }
    nloc = mine > 0u ? mine : 1u; nx = cnt > 0u ? cnt : 1u;
}

__device__ __forceinline__ void xcd_barrier(const XcdBarrier& b) {
    asm volatile("s_waitcnt vmcnt(0)" ::: "memory");
    __syncthreads();
    if (b.w0 && pg8::fresh_lane() == 0) {
        unsigned* bar = b.bar;
        __builtin_amdgcn_s_waitcnt(0);
        unsigned nloc = b.st[0], nx = b.st[1];
        if (nloc == 0u) { xcd_barrier_complete(bar, b.x, nloc, nx); b.st[0] = nloc; b.st[1] = nx; }
        const unsigned old = xb_add(&bar[XB_XSUB(b.x)], 1u);
        const unsigned gen = old / nloc;
        if (old + 1u == (gen + 1u) * nloc) {
            __builtin_amdgcn_fence(__ATOMIC_RELEASE, "agent");
            asm volatile("s_waitcnt vmcnt(0)" ::: "memory");
            const unsigned og = xb_add(&bar[XB_TOP], 1u);
            const unsigned tg = og / nx;
            if (og + 1u == (tg + 1u) * nx) xb_add(&bar[XB_TOPGEN], 1u);
            else XB_SPIN(xb_ld(&bar[XB_TOPGEN]) == tg, bar);
            __builtin_amdgcn_fence(__ATOMIC_ACQUIRE, "agent");
            xb_add(&bar[XB_XGEN(b.x)], 1u);
            asm volatile("s_waitcnt vmcnt(0)" ::: "memory");
        } else {
            XB_SPIN(xb_ld(&bar[XB_XGEN(b.x)]) == gen, bar);
            __builtin_amdgcn_fence(__ATOMIC_ACQUIRE, "agent");
            asm volatile("s_waitcnt vmcnt(0)" ::: "memory");
        }
    }
    __syncthreads();
}

struct Frame {
    LAS unsigned char* lds;
    volatile LAS unsigned* MISC;
    gu32* ctl;
    int tid, lane, wave;
    int vcu, G;
    const float* in[14];
    float* out; unsigned char* ws;
};
__device__ __forceinline__ float bf2f(unsigned short b) { return __uint_as_float(((unsigned)b) << 16); }
__device__ __forceinline__ float bflo(unsigned w) { return __uint_as_float(w << 16); }
__device__ __forceinline__ float bfhi(unsigned w) { return __uint_as_float(w & 0xffff0000u); }
__device__ __forceinline__ float wave_sum(float v) {
#pragma unroll
    for (int o = 1; o < 64; o <<= 1) v += __shfl_xor(v, o);
    return v;
}
__device__ __forceinline__ float wave_max(float v) {
#pragma unroll
    for (int o = 1; o < 64; o <<= 1) v = fmaxf(v, __shfl_xor(v, o));
    return v;
}
typedef short s16x4 __attribute__((ext_vector_type(4)));
#define TR16(p) __builtin_amdgcn_ds_read_tr16_b64_v4i16((LAS s16x4*)(p))
#define MFMA16(a, b, c) __builtin_amdgcn_mfma_f32_16x16x32_bf16((a), (b), (c), 0, 0, 0)
__device__ __forceinline__ bf16x8 cat8(s16x4 a, s16x4 b) { return (bf16x8){a[0], a[1], a[2], a[3], b[0], b[1], b[2], b[3]}; }
__device__ __forceinline__ float logsig16(float x) { return (fminf(x, 0.f) - 0.6931471805599453f * __builtin_amdgcn_logf(1.0f + __builtin_amdgcn_exp2f(-1.4426950408889634f * fabsf(x)))) * (1.0f / 16.0f); }
__device__ __forceinline__ void p0_tr_load(f32x4 (&t)[16], const float* W, int N, int ldw, int item, int lane, const float* gk, unsigned* cmax = nullptr) {
    const int nblk = N / 64, kb = item / nblk, nb = item % nblk, k0 = 64 * kb, n0 = 64 * nb, ks = lane >> 4, n4 = (lane & 15) * 4;
#pragma unroll
    for (int i = 0; i < 16; ++i) t[i] = *(const GAS f32x4*)(W + (size_t)(k0 + 4 * i + ks) * ldw + n0 + n4);
    if (gk) {
#pragma unroll
        for (int i = 0; i < 16; ++i) t[i] = t[i] * gk[k0 + 4 * i + ks]; }
    if (cmax) {
        f32x4 mx = (f32x4){0.f, 0.f, 0.f, 0.f};
#pragma unroll
        for (int i = 0; i < 16; ++i) { mx.x = fmaxf(mx.x, fabsf(t[i].x)); mx.y = fmaxf(mx.y, fabsf(t[i].y)); mx.z = fmaxf(mx.z, fabsf(t[i].z)); mx.w = fmaxf(mx.w, fabsf(t[i].w)); }
#pragma unroll
        for (int o = 16; o < 64; o <<= 1) { mx.x = fmaxf(mx.x, __shfl_xor(mx.x, o)); mx.y = fmaxf(mx.y, __shfl_xor(mx.y, o)); mx.z = fmaxf(mx.z, __shfl_xor(mx.z, o)); mx.w = fmaxf(mx.w, __shfl_xor(mx.w, o)); }
        if (ks == 0) { unsigned* c = cmax + n0 + n4; atomicMax(c, __float_as_uint(mx.x)); atomicMax(c + 1, __float_as_uint(mx.y)); atomicMax(c + 2, __float_as_uint(mx.z)); atomicMax(c + 3, __float_as_uint(mx.w)); } }
}
__device__ __forceinline__ int convmap(int n) { return (n >= 1024 && n < 3072) ? (1024 + (((n - 1024) & 1023) >> 7) * 256 + (n >= 2048 ? 128 : 0) + (n & 127)) : n; }
template <bool REMAP> __device__ __forceinline__ void p0_tr_store(const f32x4 (&t)[16], int K, int N, bf16* WT, LAS float* scr, int item, int lane) {
    const int nblk = N / 64, kb = item / nblk, nb = item % nblk, k0 = 64 * kb, ks = lane >> 4, n4 = (lane & 15) * 4; const int n0 = REMAP ? convmap(64 * nb) : 64 * nb;
#pragma unroll
    for (int i = 0; i < 16; ++i) { LAS float* d = scr + (4 * i + ks) * 65 + n4; d[0] = t[i].x; d[1] = t[i].y; d[2] = t[i].z; d[3] = t[i].w; }
    LDS_WAIT(); asm volatile("" ::: "memory");
    const int c = lane & 7;
#pragma unroll
    for (int j = 0; j < 8; ++j) { const int n = (lane >> 3) + 8 * j; const LAS float* s = scr + (8 * c) * 65 + n;
        v4u o; o.x = pk2(s[0 * 65], s[1 * 65]); o.y = pk2(s[2 * 65], s[3 * 65]); o.z = pk2(s[4 * 65], s[5 * 65]); o.w = pk2(s[6 * 65], s[7 * 65]);
        *(GAS v4u*)(WT + (size_t)(n0 + n) * K + k0 + 8 * c) = o; }
    LDS_WAIT(); asm volatile("" ::: "memory");
}
__device__ __forceinline__ void p0_tr_store8(const f32x4 (&t)[16], int K, int N, unsigned char* WT, LAS float* scr, int item, int lane, float sc) {
    const int nblk = N / 64, kb = item / nblk, nb = item % nblk, k0 = 64 * kb, ks = lane >> 4, n4 = (lane & 15) * 4; const int n0 = 64 * nb;
#pragma unroll
    for (int i = 0; i < 16; ++i) { LAS float* d = scr + (4 * i + ks) * 65 + n4; d[0] = t[i].x; d[1] = t[i].y; d[2] = t[i].z; d[3] = t[i].w; }
    LDS_WAIT(); asm volatile("" ::: "memory");
    const int c = lane & 7;
#pragma unroll
    for (int j = 0; j < 8; ++j) { const int n = (lane >> 3) + 8 * j; const LAS float* s = scr + (8 * c) * 65 + n;
        pg8::u32x2 o; o.x = pg8::pk4_fp8(s[0 * 65] * sc, s[1 * 65] * sc, s[2 * 65] * sc, s[3 * 65] * sc); o.y = pg8::pk4_fp8(s[4 * 65] * sc, s[5 * 65] * sc, s[6 * 65] * sc, s[7 * 65] * sc);
        *(GAS pg8::u32x2*)(WT + (size_t)(n0 + n) * K + k0 + 8 * c) = o; }
    LDS_WAIT(); asm volatile("" ::: "memory");
}
__device__ __forceinline__ void transpose_all8(Frame& F, const float* W, int K, int N, int ldw, unsigned char* WT, const float* gk, float sc) {
    LAS float* scr = (LAS float*)(F.lds + RING_OFF + F.wave * 16640);
    const int gw = F.vcu * NWAVES + F.wave, NGW = F.G * NWAVES, nitems = (K / 64) * (N / 64);
    int it = gw; if (it >= nitems) return;
    f32x4 t[16], t2[16];
    p0_tr_load(t, W, N, ldw, it, F.lane, gk);
    for (;;) { const int nx = it + NGW; const bool more = nx < nitems;
        if (more) p0_tr_load(t2, W, N, ldw, nx, F.lane, gk);
        p0_tr_store8(t, K, N, WT, scr, it, F.lane, sc);
        if (!more) break;
#pragma unroll
        for (int i = 0; i < 16; ++i) t[i] = t2[i];
        it = nx; }
}
template <bool REMAP = false> __device__ __forceinline__ void transpose_all(Frame& F, const float* W, int K, int N, int ldw, bf16* WT, const float* gk = nullptr, unsigned* cmax = nullptr) {
    LAS float* scr = (LAS float*)(F.lds + RING_OFF + F.wave * 16640);
    const int gw = F.vcu * NWAVES + F.wave, NGW = F.G * NWAVES, nitems = (K / 64) * (N / 64);
    int it = gw; if (it >= nitems) return;
    f32x4 t[16], t2[16];
    p0_tr_load(t, W, N, ldw, it, F.lane, gk, cmax);
    for (;;) { const int nx = it + NGW; const bool more = nx < nitems;
        if (more) p0_tr_load(t2, W, N, ldw, nx, F.lane, gk, cmax);
        p0_tr_store<REMAP>(t, K, N, WT, scr, it, F.lane);
        if (!more) break;
#pragma unroll
        for (int i = 0; i < 16; ++i) t[i] = t2[i];
        it = nx; }
}

__device__ __forceinline__ void quant_rows_i8(Frame& F, const bf16* WT, unsigned char* W8, const unsigned* cmax, int N, int K) {
    const int gw = F.vcu * NWAVES + F.wave, NGW = F.G * NWAVES;
    for (int n = gw; n < N; n += NGW) { const float sc = 127.0f / fmaxf(__uint_as_float(cmax[n]), 1e-30f);
        const bf16* src = WT + (size_t)n * K + 8 * F.lane; unsigned char* dst = W8 + (size_t)n * K + 8 * F.lane;
        for (int j = 0; j < K / 512; ++j) { const v4u w = *(const GAS v4u*)(src + 512 * j); pg8::u32x2 o;
            o.x = pg8::pk4_i8(bflo(w.x) * sc, bfhi(w.x) * sc, bflo(w.y) * sc, bfhi(w.y) * sc); o.y = pg8::pk4_i8(bflo(w.z) * sc, bfhi(w.z) * sc, bflo(w.w) * sc, bfhi(w.w) * sc);
            *(GAS pg8::u32x2*)(dst + 512 * j) = o; } }
}
__device__ __forceinline__ void conv_set_a(Frame& F) {
    const float* w1 = F.in[12]; const float* w2 = F.in[13];
    transpose_all(F, w2, FF, D, D, (bf16*)(F.ws + WS_WB + 32 * MiB));
    transpose_all(F, w1 + (size_t)D * FF, D, FF, FF, (bf16*)(F.ws + WS_WC), F.in[2] + D, (unsigned*)(F.ws + WS_CTL + CMAX1_OFF));
    transpose_all(F, w2 + (size_t)D * FF, FF, D, D, (bf16*)(F.ws + WS_WC + 32 * MiB));
}
__device__ __forceinline__ void conv_set_b(Frame& F) {
    transpose_all(F, F.in[9], D, D, D, (bf16*)(F.ws + WS_WA + 24 * MiB));
    transpose_all(F, F.in[12], D, FF, FF, (bf16*)(F.ws + WS_WB), F.in[2], (unsigned*)(F.ws + WS_CTL + CMAX0_OFF));
    transpose_all(F, F.in[10], D, NPROJ, NPROJ, (bf16*)(F.ws + WS_WA), F.in[1] + D, (unsigned*)(F.ws + WS_CTL + CMAXQ_OFF));
    transpose_all(F, F.in[11], D, D, D, (bf16*)((unsigned char*)F.out + OUT_WO));
}
__device__ __forceinline__ void p0_prologue(Frame& F) {
    const float* w_in = F.in[4];
    transpose_all<true>(F, w_in, D, NPROJ, INCOLS, (bf16*)(F.ws + WS_WA));
    const int gw = F.vcu * NWAVES + F.wave, NGW = F.G * NWAVES;
    const float* x = F.in[0]; const float* g = F.in[1];
    bf16* XN = (bf16*)(F.ws + WS_ACT);
    for (int m = gw; m < M; m += NGW) {
        const GAS f32x4* xr = (const GAS f32x4*)(x + (size_t)m * D) + F.lane;
        f32x4 v[8]; float s = 0.f;
#pragma unroll
        for (int j = 0; j < 8; ++j) { v[j] = xr[64 * j]; s += (v[j].x * v[j].x + v[j].y * v[j].y) + (v[j].z * v[j].z + v[j].w * v[j].w); }
        const float ssum = wave_sum(s); const float rstd = 1.0f / sqrtf(ssum * (1.f / D) + EPS);
        if (F.lane == 0) ((unsigned long long*)(F.ws + WS_CTL + SSX_OFF))[m] = (unsigned long long)(ssum * 1048576.0f + 0.5f);
        GAS unsigned long long* o8 = (GAS unsigned long long*)(XN + (size_t)m * D) + F.lane;
#pragma unroll
        for (int j = 0; j < 8; ++j) { const f32x4 gg = *((const GAS f32x4*)g + F.lane + 64 * j); v[j] = v[j] * gg * rstd;
            o8[64 * j] = (unsigned long long)pk2(v[j].x, v[j].y) | ((unsigned long long)pk2(v[j].z, v[j].w) << 32); }
    }
}
__device__ __forceinline__ void glow_mfma(Frame& F) {
    constexpr int WS_ = 2056;
    LAS bf16* WgT = (LAS bf16*)F.lds; const float* w_in = F.in[4]; const bf16* XN = (const bf16*)(F.ws + WS_ACT); float* GL = (float*)(F.ws + WS_GLOW);
    for (int k = F.tid; k < D; k += NWAVES * 64) { const f32x4* p = (const f32x4*)(w_in + (size_t)k * INCOLS + O_GL); const f32x4 a = p[0], b = p[1], c = p[2], d = p[3];
        const float vv[16] = {a.x, a.y, a.z, a.w, b.x, b.y, b.z, b.w, c.x, c.y, c.z, c.w, d.x, d.y, d.z, d.w};
#pragma unroll
        for (int cc = 0; cc < 16; ++cc) WgT[cc * WS_ + k] = (bf16)f2bf(vv[cc]); }
    __syncthreads();
    const int g = F.lane >> 4, li = F.lane & 15;
    for (int task = F.wave * F.G + (int)blockIdx.x; task < M / 16; task += F.G * NWAVES) { const size_t m0 = (size_t)task * 16;
        f32x4 acc = (f32x4){0.f, 0.f, 0.f, 0.f}; const bf16* ap = XN + (m0 + li) * D + 8 * g; const LAS bf16* bp = WgT + li * WS_ + 8 * g;
#pragma unroll 16
        for (int ks = 0; ks < 64; ++ks) acc = MFMA16(*(const bf16x8*)(ap + 32 * ks), *(const LAS bf16x8*)(bp + 32 * ks), acc);
#pragma unroll
        for (int r = 0; r < 4; ++r) GL[(m0 + 4 * g + r) * 16 + li] = acc[r]; }
    __syncthreads();
}
__device__ __forceinline__ void unpack8(const v4u w, float (&f)[8]) { f[0] = bflo(w.x); f[1] = bfhi(w.x); f[2] = bflo(w.y); f[3] = bfhi(w.y); f[4] = bflo(w.z); f[5] = bfhi(w.z); f[6] = bflo(w.w); f[7] = bfhi(w.w); }
__device__ __forceinline__ void conv_mix(Frame& F) {
    const bf16* PROJ = (const bf16*)(F.ws + WS_PROJ); bf16* Y = (bf16*)(F.ws + WS_Y); const float* cw = F.in[5];
    for (int idx = blockIdx.x * NWAVES * 64 + F.tid; idx < (M / 16) * 128; idx += F.G * NWAVES * 64) { const int cg = idx & 127, c = cg * 8; const size_t m0 = (size_t)(idx >> 7) * 16; const int t0 = (int)(m0 & (T - 1));
        float w0[8], w1[8], w2[8];
#pragma unroll
        for (int e2 = 0; e2 < 8; ++e2) { w0[e2] = cw[c + e2]; w1[e2] = cw[1024 + c + e2]; w2[e2] = cw[2048 + c + e2]; }
        float u1[8], u2[8];
#pragma unroll
        for (int e2 = 0; e2 < 8; ++e2) { u1[e2] = 0.f; u2[e2] = 0.f; }
        if (t0 > 0) { unpack8(*(const v4u*)(PROJ + (m0 - 1) * NPROJ + O_CC + c), u1); unpack8(*(const v4u*)(PROJ + (m0 - 2) * NPROJ + O_CC + c), u2); }
#pragma unroll 4
        for (int i = 0; i < 16; ++i) { const bf16* row = PROJ + (m0 + i) * NPROJ; float ab[8], u0[8], y[8];
            unpack8(*(const v4u*)(row + O_CB + c), ab); unpack8(*(const v4u*)(row + O_CC + c), u0);
#pragma unroll
            for (int e2 = 0; e2 < 8; ++e2) { y[e2] = ab[e2] * (w0[e2] * u2[e2] + w1[e2] * u1[e2] + w2[e2] * u0[e2]); u2[e2] = u1[e2]; u1[e2] = u0[e2]; }
            v4u o; o.x = pk2(y[0], y[1]); o.y = pk2(y[2], y[3]); o.z = pk2(y[4], y[5]); o.w = pk2(y[6], y[7]);
            *(v4u*)(Y + (m0 + i) * D + c) = o; } }
}
typedef _Float16 h16; typedef _Float16 h16x8 __attribute__((ext_vector_type(8)));
__device__ __forceinline__ void unpack_h8(const v4u w, float* f) { const h16x8 h = __builtin_bit_cast(h16x8, w);
#pragma unroll
    for (int i = 0; i < 8; ++i) f[i] = (float)h[i]; }
constexpr int KS = 136, VS = 264;
constexpr size_t WS_GB = WS_ACT, WS_SLOC = WS_ACT + 32 * MiB, DV_OFF = 768 * 1024;
__device__ __forceinline__ void stage_v64(const bf16* src  , LAS bf16* Vs, int tid) {
#pragma unroll
    for (int r = 0; r < 4; ++r) { const int idx = tid + 512 * r, row = idx >> 5, pc = idx & 31;
        const v4u val = *(const v4u*)(src + (size_t)row * NPROJ + pc * 8); *(LAS v4u*)(Vs + row * VS + pc * 8) = val; }
}
__device__ __forceinline__ void gla_g1(Frame& F) {
    const bf16* PROJ = (const bf16*)(F.ws + WS_PROJ); const float* GL = (const float*)(F.ws + WS_GLOW);
    h16* GB = (h16*)(F.ws + WS_GB); float* SLOC = (float*)(F.ws + WS_SLOC); float* DV = (float*)(F.ws + WS_CTL + DV_OFF);
    const float* wg2 = F.in[6]; const float* bg = F.in[7];
    LAS float* qtot = (LAS float*)(F.lds); LAS bf16* Kh = (LAS bf16*)(F.lds + 2048); LAS bf16* Vs = (LAS bf16*)(F.lds + 2048 + 64 * KS * 2);
    LAS float* GLs = (LAS float*)(F.lds + 2048 + 64 * KS * 2 + 64 * VS * 2);
    const int w = F.wave;
    for (int u = blockIdx.x; u < 256; u += F.G) { const int bh = u >> 4, s = u & 15, b = bh >> 2, h = bh & 3; const size_t m0 = (size_t)b * T + s * 256;
        int tid = F.tid; asm volatile("" : "+v"(tid));
        const int ch = tid & 127, q = tid >> 7, g = (tid >> 4) & 3, li = tid & 15, tq = li >> 2, tp = li & 3;
        unsigned short kraw[16]; v4u vraw[4];
#define G1_LOAD(c_) do { const size_t mb_ = m0 + (c_) * 64 + q * 16; _Pragma("unroll") for (int i = 0; i < 16; ++i) kraw[i] = PROJ[(mb_ + i) * NPROJ + O_K + h * 128 + ch]; \
            _Pragma("unroll") for (int r = 0; r < 4; ++r) { const int idx = tid + 512 * r, row = idx >> 5, pc = idx & 31; vraw[r] = *(const v4u*)(PROJ + (m0 + (c_) * 64 + row) * NPROJ + O_V + h * 256 + pc * 8); } } while (0)
        { const f32x4* gp = (const f32x4*)(GL + m0 * 16) + tid; const f32x4 g0 = gp[0], g1 = gp[512]; G1_LOAD(3);
          *((LAS f32x4*)GLs + tid) = g0; *((LAS f32x4*)GLs + 512 + tid) = g1; }
        float wg[16];
#pragma unroll
        for (int j = 0; j < 16; ++j) wg[j] = wg2[j * 512 + h * 128 + ch];
        const float bias = bg[h * 128 + ch];
        f32x4 acc[8][2];
#pragma unroll
        for (int rt = 0; rt < 8; ++rt) { acc[rt][0] = (f32x4){0.f, 0.f, 0.f, 0.f}; acc[rt][1] = (f32x4){0.f, 0.f, 0.f, 0.f}; }
        float suffix = 0.f;
        __syncthreads();
        for (int c = 3; c >= 0; --c) {
            float loc[16]; float run = 0.f; const size_t mb = m0 + c * 64 + q * 16;
#pragma unroll
            for (int i = 0; i < 16; ++i) { const LAS f32x4* gl = (const LAS f32x4*)(GLs + (c * 64 + q * 16 + i) * 16); const f32x4 a0 = gl[0], a1 = gl[1], a2 = gl[2], a3 = gl[3];
                const float xx = bias + ((a0.x * wg[0] + a0.y * wg[1]) + (a0.z * wg[2] + a0.w * wg[3])) + ((a1.x * wg[4] + a1.y * wg[5]) + (a1.z * wg[6] + a1.w * wg[7]))
                                      + ((a2.x * wg[8] + a2.y * wg[9]) + (a2.z * wg[10] + a2.w * wg[11])) + ((a3.x * wg[12] + a3.y * wg[13]) + (a3.z * wg[14] + a3.w * wg[15]));
                run += logsig16(xx); loc[i] = run; }
            qtot[q * 128 + ch] = run; __syncthreads();
            float pre = 0.f, ctot = 0.f;
#pragma unroll
            for (int qq = 0; qq < 4; ++qq) { const float v = qtot[qq * 128 + ch]; ctot += v; if (qq < q) pre += v; }
#pragma unroll
            for (int i = 0; i < 16; ++i) { const float gi = pre + loc[i]; GB[(mb + i) * 512 + h * 128 + ch] = (h16)gi;
                Kh[(q * 16 + i) * KS + ch] = (bf16)f2bf(bf2f(kraw[i]) * __builtin_amdgcn_exp2f(1.4426950408889634f * ((ctot - gi) + suffix))); }
#pragma unroll
            for (int r = 0; r < 4; ++r) { const int idx = tid + 512 * r, row = idx >> 5, pc = idx & 31; *(LAS v4u*)(Vs + row * VS + pc * 8) = vraw[r]; }
            __syncthreads();
            if (c > 0) G1_LOAD(c - 1);
#pragma unroll
            for (int ks = 0; ks < 2; ++ks) { const int j0 = 32 * ks + 8 * g + tq; bf16x8 bfr[2];
#pragma unroll
                for (int ct = 0; ct < 2; ++ct) { const LAS bf16* p = Vs + j0 * VS + 32 * w + 16 * ct + 4 * tp; bfr[ct] = cat8(TR16(p), TR16(p + 4 * VS)); }
#pragma unroll
                for (int rt = 0; rt < 8; ++rt) { const LAS bf16* p = Kh + j0 * KS + 16 * rt + 4 * tp; const bf16x8 af = cat8(TR16(p), TR16(p + 4 * KS));
                    acc[rt][0] = MFMA16(af, bfr[0], acc[rt][0]); acc[rt][1] = MFMA16(af, bfr[1], acc[rt][1]); } }
            suffix += ctot;
            __syncthreads();
        }
#undef G1_LOAD
        if (q == 0) DV[(bh * 16 + s) * 128 + ch] = __builtin_amdgcn_exp2f(1.4426950408889634f * suffix);
        float* so = SLOC + (size_t)(bh * 16 + s) * 128 * 256;
#pragma unroll
        for (int rt = 0; rt < 8; ++rt)
#pragma unroll
            for (int ct = 0; ct < 2; ++ct)
#pragma unroll
                for (int r = 0; r < 4; ++r) so[(size_t)(16 * rt + 4 * g + r) * 256 + 32 * w + 16 * ct + li] = acc[rt][ct][r];
    }
}
__device__ __forceinline__ void gla_g2(Frame& F) {
    const float* SLOC = (const float*)(F.ws + WS_SLOC); const float* DV = (const float*)(F.ws + WS_CTL + DV_OFF); bf16* SST = (bf16*)F.out;
    for (int idx = blockIdx.x * NWAVES * 64 + F.tid; idx < 16 * 128 * 64; idx += F.G * NWAVES * 64) { const int vq = idx & 63, ch = (idx >> 6) & 127, bh = idx >> 13;
        f32x4 st = (f32x4){0.f, 0.f, 0.f, 0.f};
#pragma unroll 4
        for (int s = 0; s < 16; ++s) { const size_t o = ((size_t)(bh * 16 + s) * 128 + ch) * 256 + vq * 4;
            *(unsigned long long*)(SST + o) = (unsigned long long)pk2(st.x, st.y) | ((unsigned long long)pk2(st.z, st.w) << 32);
            const f32x4 loc = *(const f32x4*)(SLOC + o); const float d = DV[(bh * 16 + s) * 128 + ch]; st = st * d + loc; } }
}
__device__ __forceinline__ float fexp(float x) { return __builtin_amdgcn_exp2f(x * 1.4426950408889634f); }
struct G3Raw { v4u k0, k1, v[4]; v4u g[2]; };
__device__ __forceinline__ void g3_load_raw(G3Raw& R, const bf16* PROJ, const h16* GB, size_t mrow0  , int h, int srow, int spc, int tid) {
    const size_t m = mrow0 + srow; const v4u* kp = (const v4u*)(PROJ + m * NPROJ + O_K + h * 128 + spc * 16); R.k0 = kp[0]; R.k1 = kp[1];
    const v4u* gp = (const v4u*)(GB + m * 512 + h * 128 + spc * 16); R.g[0] = gp[0]; R.g[1] = gp[1];
#pragma unroll
    for (int r = 0; r < 4; ++r) { const int idx = tid + 512 * r, row = idx >> 5, pc = idx & 31; R.v[r] = *(const v4u*)(PROJ + (mrow0 + row) * NPROJ + O_V + h * 256 + pc * 8); }
}
__device__ __forceinline__ void gla_g3(Frame& F) {
    const bf16* PROJ = (const bf16*)(F.ws + WS_PROJ); const h16* GB = (const h16*)(F.ws + WS_GB); const bf16* SST = (const bf16*)F.out; bf16* Y = (bf16*)(F.ws + WS_Y); const float* gn = F.in[8];
    LAS bf16* QT = (LAS bf16*)(F.lds); LAS bf16* Q2 = (LAS bf16*)(F.lds + 17408); LAS bf16* Sx = (LAS bf16*)(F.lds + 34816);
    LAS bf16* KT = Sx; LAS bf16* Vs = (LAS bf16*)(F.lds + 34816 + 17408); LAS float* RED = (LAS float*)(F.lds + 102400); LAS float* CT = (LAS float*)(F.lds + 102912);
    const int w = F.wave, ti = w & 3, vh = w >> 2;
    const float qscale = 0.08838834764831845f;
    for (int uu = blockIdx.x; uu < 1024; uu += F.G) { const int nl = 3 - (uu >> 8), cu = uu & 255, bh = cu >> 4, s = cu & 15, b = bh >> 2, h = bh & 3;
        const size_t m0 = (size_t)b * T + s * 256, mq = m0 + nl * 64;
        int tid = F.tid; asm volatile("" : "+v"(tid));
        const int g = (tid >> 4) & 3, li = tid & 15, tq = li >> 2, tp = li & 3, srow = tid >> 3, spc = tid & 7;
        const float ctv = (float)GB[(m0 + (tid >> 7) * 64 + 63) * 512 + h * 128 + (tid & 127)];
        const size_t mqr = mq + srow; const v4u* qp = (const v4u*)(PROJ + mqr * NPROJ + O_Q + h * 128 + spc * 16); const v4u qa = qp[0], qb = qp[1];
        const v4u* gqp = (const v4u*)(GB + mqr * 512 + h * 128 + spc * 16); const v4u gq0 = gqp[0], gq1 = gqp[1];
        v4u sraw[8];
        { const bf16* sp = SST + (size_t)(bh * 16 + s) * 128 * 256;
#pragma unroll
            for (int r = 0; r < 8; ++r) { const int idx = tid + 512 * r, row = idx >> 5, pc = idx & 31; sraw[r] = *(const v4u*)(sp + (size_t)row * 256 + pc * 8); } }
        G3Raw R; g3_load_raw(R, PROJ, GB, m0, h, srow, spc, tid);
        CT[tid] = ctv;
        __syncthreads();
        float cpre[16];
#pragma unroll
        for (int e2 = 0; e2 < 16; ++e2) { float a = 0.f; for (int c = 0; c < nl; ++c) a += CT[c * 128 + spc * 16 + e2]; cpre[e2] = a; }
        {
            const unsigned qw[8] = {qa.x, qa.y, qa.z, qa.w, qb.x, qb.y, qb.z, qb.w}; float gg[16]; unpack_h8(gq0, gg); unpack_h8(gq1, gg + 8);
            unsigned o1[8], o2[8];
#pragma unroll
            for (int e2 = 0; e2 < 8; ++e2) { const float x0 = bflo(qw[e2]) * qscale * fexp(gg[2 * e2]), x1 = bfhi(qw[e2]) * qscale * fexp(gg[2 * e2 + 1]);
                o1[e2] = pg8::cvt_pk_bf16(x0, x1); o2[e2] = pg8::cvt_pk_bf16(x0 * fexp(cpre[2 * e2]), x1 * fexp(cpre[2 * e2 + 1])); }
            LAS v4u* d1 = (LAS v4u*)(QT + srow * KS + spc * 16); d1[0] = (v4u){o1[0], o1[1], o1[2], o1[3]}; d1[1] = (v4u){o1[4], o1[5], o1[6], o1[7]};
            LAS v4u* d2 = (LAS v4u*)(Q2 + srow * KS + spc * 16); d2[0] = (v4u){o2[0], o2[1], o2[2], o2[3]}; d2[1] = (v4u){o2[4], o2[5], o2[6], o2[7]};
        }
#pragma unroll
        for (int r = 0; r < 8; ++r) { const int idx = tid + 512 * r, row = idx >> 5, pc = idx & 31; *(LAS v4u*)(Sx + row * VS + pc * 8) = sraw[r]; }
        __syncthreads();
        f32x4 o[8];
#pragma unroll
        for (int vt = 0; vt < 8; ++vt) o[vt] = (f32x4){0.f, 0.f, 0.f, 0.f};
#pragma unroll
        for (int ks = 0; ks < 4; ++ks) { const bf16x8 qf2 = *(const LAS bf16x8*)(Q2 + (16 * ti + li) * KS + 32 * ks + 8 * g);
#pragma unroll
            for (int vt = 0; vt < 8; ++vt) { const LAS bf16* p = Sx + (32 * ks + 8 * g + tq) * VS + 128 * vh + 16 * vt + 4 * tp; o[vt] = MFMA16(cat8(TR16(p), TR16(p + 4 * VS)), qf2, o[vt]); } }
        bf16x8 qf[4];
#pragma unroll
        for (int ks = 0; ks < 4; ++ks) qf[ks] = *(const LAS bf16x8*)(QT + (16 * ti + li) * KS + 32 * ks + 8 * g);
        __syncthreads();
        unsigned long long rraw[8];
        const size_t mtok = mq + 16 * ti + li;
        for (int jc = 0; jc <= nl; ++jc) {
            {
                const unsigned kw[8] = {R.k0.x, R.k0.y, R.k0.z, R.k0.w, R.k1.x, R.k1.y, R.k1.z, R.k1.w};
                float gg[16]; unpack_h8(R.g[0], gg); unpack_h8(R.g[1], gg + 8);
                unsigned o1[8];
#pragma unroll
                for (int e2 = 0; e2 < 8; ++e2) o1[e2] = pg8::cvt_pk_bf16(bflo(kw[e2]) * fexp(cpre[2 * e2] - gg[2 * e2]), bfhi(kw[e2]) * fexp(cpre[2 * e2 + 1] - gg[2 * e2 + 1]));
                LAS v4u* d1 = (LAS v4u*)(KT + srow * KS + spc * 16); d1[0] = (v4u){o1[0], o1[1], o1[2], o1[3]}; d1[1] = (v4u){o1[4], o1[5], o1[6], o1[7]};
#pragma unroll
                for (int r = 0; r < 4; ++r) { const int idx = tid + 512 * r, row = idx >> 5, pc = idx & 31; *(LAS v4u*)(Vs + row * VS + pc * 8) = R.v[r]; }
#pragma unroll
                for (int e2 = 0; e2 < 16; ++e2) cpre[e2] -= CT[jc * 128 + spc * 16 + e2];
            }
            __syncthreads();
            if (jc < nl) g3_load_raw(R, PROJ, GB, m0 + (jc + 1) * 64, h, srow, spc, tid);
            else {
#pragma unroll
                for (int vt = 0; vt < 8; ++vt) rraw[vt] = *(const unsigned long long*)(PROJ + mtok * NPROJ + O_R + h * 256 + 128 * vh + 16 * vt + 4 * g); }
            f32x4 sc[4];
#pragma unroll
            for (int jt = 0; jt < 4; ++jt) { sc[jt] = (f32x4){0.f, 0.f, 0.f, 0.f};
#pragma unroll
                for (int ks = 0; ks < 4; ++ks) sc[jt] = MFMA16(*(const LAS bf16x8*)(KT + (16 * jt + li) * KS + 32 * ks + 8 * g), qf[ks], sc[jt]); }
            if (jc == nl) {
#pragma unroll
                for (int jt = 0; jt < 4; ++jt)
#pragma unroll
                    for (int r = 0; r < 4; ++r) if (16 * jt + 4 * g + r > 16 * ti + li) sc[jt][r] = 0.f; }
#pragma unroll
            for (int k2 = 0; k2 < 2; ++k2) { const f32x4 s0 = sc[2 * k2], s1 = sc[2 * k2 + 1];
                v4u pw; pw.x = pg8::cvt_pk_bf16(s0[0], s0[1]); pw.y = pg8::cvt_pk_bf16(s0[2], s0[3]); pw.z = pg8::cvt_pk_bf16(s1[0], s1[1]); pw.w = pg8::cvt_pk_bf16(s1[2], s1[3]);
                const bf16x8 pf = __builtin_bit_cast(bf16x8, pw);
#pragma unroll
                for (int vt = 0; vt < 8; ++vt) { const LAS bf16* p = Vs + (32 * k2 + 4 * g + tq) * VS + 128 * vh + 16 * vt + 4 * tp; o[vt] = MFMA16(cat8(TR16(p), TR16(p + 16 * VS)), pf, o[vt]); } }
            __syncthreads();
        }
        float a = 0.f;
#pragma unroll
        for (int vt = 0; vt < 8; ++vt) a += (o[vt][0] * o[vt][0] + o[vt][1] * o[vt][1]) + (o[vt][2] * o[vt][2] + o[vt][3] * o[vt][3]);
        a += __shfl_xor(a, 16); a += __shfl_xor(a, 32);
        if (g == 0) RED[(16 * ti + li) * 2 + vh] = a;
        __syncthreads();
        const float rstd = __builtin_amdgcn_rsqf((RED[(16 * ti + li) * 2] + RED[(16 * ti + li) * 2 + 1]) * (1.f / 256.f) + EPS);
        bf16* yp = Y + mtok * D + 1024 + h * 256 + 128 * vh + 4 * g;
#pragma unroll
        for (int vt = 0; vt < 8; ++vt) { const f32x4 gv = *(const f32x4*)(gn + 128 * vh + 16 * vt + 4 * g); const unsigned long long rw = rraw[vt];
            const float r0 = bflo((unsigned)rw), r1 = bfhi((unsigned)rw), r2 = bflo((unsigned)(rw >> 32)), r3 = bfhi((unsigned)(rw >> 32));
            const float y0 = o[vt][0] * rstd * gv.x * r0 * __builtin_amdgcn_rcpf(1.f + fexp(-r0)), y1 = o[vt][1] * rstd * gv.y * r1 * __builtin_amdgcn_rcpf(1.f + fexp(-r1));
            const float y2 = o[vt][2] * rstd * gv.z * r2 * __builtin_amdgcn_rcpf(1.f + fexp(-r2)), y3 = o[vt][3] * rstd * gv.w * r3 * __builtin_amdgcn_rcpf(1.f + fexp(-r3));
            *(unsigned long long*)(yp + 16 * vt) = (unsigned long long)pg8::cvt_pk_bf16(y0, y1) | ((unsigned long long)pg8::cvt_pk_bf16(y2, y3) << 32); }
    }
}
constexpr int AKS = 136;
constexpr int ASLOT = 2 * 128 * AKS;
constexpr int KVP = 6144;
template <int DIL> __device__ __forceinline__ void attn_load_block(v4u (&R)[4], const char* ubase, bool valid, unsigned loff) {
#pragma unroll
    for (int it = 0; it < 4; ++it) { R[it] = (v4u){0u, 0u, 0u, 0u};
        if (valid) R[it] = *(const v4u*)(ubase + (size_t)(64 * (it & 1)) * DIL * KVP + (it >> 1) * 2048 + loff); }
}
typedef float f32x2_ __attribute__((ext_vector_type(2)));
__device__ __forceinline__ unsigned fp8lo_to_bf16(unsigned w) { const f32x2_ a = __builtin_amdgcn_cvt_pk_f32_fp8((int)w, false); return pg8::cvt_pk_bf16(a[0], a[1]); }
__device__ __forceinline__ unsigned fp8hi_to_bf16(unsigned w) { const f32x2_ a = __builtin_amdgcn_cvt_pk_f32_fp8((int)w, true); return pg8::cvt_pk_bf16(a[0], a[1]); }
__device__ __forceinline__ void attn_store_block(const v4u (&R)[4], LAS bf16* slot, int tid) {
#pragma unroll
    for (int it = 0; it < 4; ++it) { const int kv = it >> 1, row = (tid >> 3) + 64 * (it & 1), pc = tid & 7; v4u a, b;
        a.x = fp8lo_to_bf16(R[it].x); a.y = fp8hi_to_bf16(R[it].x); a.z = fp8lo_to_bf16(R[it].y); a.w = fp8hi_to_bf16(R[it].y); b.x = fp8lo_to_bf16(R[it].z); b.y = fp8hi_to_bf16(R[it].z); b.z = fp8lo_to_bf16(R[it].w); b.w = fp8hi_to_bf16(R[it].w);
        LAS bf16* d = slot + kv * (128 * AKS) + row * AKS + pc * 16; *(LAS v4u*)d = a; *(LAS v4u*)(d + 8) = b; }
}
__device__ __forceinline__ bf16x8 q8_to_bf16(unsigned long long raw) { const unsigned lo = (unsigned)raw, hi = (unsigned)(raw >> 32);
    v4u o; o.x = fp8lo_to_bf16(lo); o.y = fp8hi_to_bf16(lo); o.z = fp8lo_to_bf16(hi); o.w = fp8hi_to_bf16(hi); return __builtin_bit_cast(bf16x8, o); }
template <int GI, bool MERGE> __device__ __forceinline__ void attn_chain(Frame& F, const int bh, const int r, const int blk0, const int nblk) {
    constexpr int DIL = (GI == 0) ? 16 : (GI == 1 ? 4 : 1);
    const bf16* PROJ = (const bf16*)(F.ws + WS_PROJ); bf16* Y = (bf16*)(F.ws + WS_Y); float* LSE = (float*)(F.ws + WS_GLOW);
    LAS bf16* S0 = (LAS bf16*)(F.lds);
    const int tid = F.tid, w = F.wave, qi0 = 16 * w;
    constexpr float L2E = 1.4426950408889634f, LN2 = 0.6931471805599453f, QK2 = 0.08838834764831845f * L2E;
    const unsigned loff = (unsigned)((tid >> 3) * DIL * KVP + (tid & 7) * 16);
    { const int b = bh >> 4, h = bh & 15;
        const float slope2 = exp2f(-0.5f * (float)(h + 1)) * (float)DIL * L2E;
        const size_t rowb = (size_t)b * T;
        const unsigned char* QKV8 = F.ws + WS_PROJ; const char* kvbase = (const char*)QKV8 + (rowb + r) * KVP + 2048 + h * 128;
        int par = 0;
        v4u R[4]; bf16x8 qf[4]; unsigned long long qnr[4];
        {
            v4u R2[4];
            attn_load_block<DIL>(R2, kvbase + (ptrdiff_t)(blk0 - 1) * 128 * DIL * KVP, blk0 > 0, loff);
            attn_load_block<DIL>(R, kvbase + (ptrdiff_t)blk0 * 128 * DIL * KVP, true, loff);
            const unsigned char* qp = QKV8 + (rowb + (size_t)(blk0 * 128 + qi0) * DIL + r + (size_t)(F.lane & 15) * DIL) * KVP + h * 128 + 8 * (F.lane >> 4);
#pragma unroll
            for (int ks = 0; ks < 4; ++ks) qnr[ks] = *(const unsigned long long*)(qp + 32 * ks);
#pragma unroll
            for (int ks = 0; ks < 4; ++ks) qf[ks] = q8_to_bf16(qnr[ks]);
            attn_store_block(R2, S0 + ASLOT, tid); attn_store_block(R, S0, tid); }
        __syncthreads();
        for (int i = 0; i < nblk; ++i) { const int blk = blk0 + i;
            int g = F.lane >> 4, li = F.lane & 15;
            asm volatile("" : "+v"(g), "+v"(li));
            const int lk = li * AKS + 8 * g, lv = (4 * g + (li >> 2)) * AKS + 4 * (li & 3), bd = 128 + li - 4 * g;
            const size_t mq0 = rowb + (size_t)(blk * 128 + qi0) * DIL + r;
            bf16* yp = Y + mq0 * D + h * 128 + (li * DIL * D + 4 * g); float* lp_ = LSE + mq0 * 16 + h + li * DIL * 16;
            unsigned long long yo[8]; float lpv = 0.f;
            if (MERGE) { lpv = *lp_;
#pragma unroll
                for (int vt = 0; vt < 8; ++vt) yo[vt] = *(const unsigned long long*)(yp + 16 * vt); }
            if (i + 1 < nblk) { attn_load_block<DIL>(R, kvbase + (ptrdiff_t)(blk + 1) * 128 * DIL * KVP, true, loff);
                const unsigned char* qp = QKV8 + (mq0 + (size_t)128 * DIL + (size_t)li * DIL) * KVP + h * 128 + 8 * g;
#pragma unroll
                for (int ks = 0; ks < 4; ++ks) qnr[ks] = *(const unsigned long long*)(qp + 32 * ks); }
            const int curo = par * ASLOT, prvo = (par ^ 1) * ASLOT;
            f32x4 sc[9];
#pragma unroll
            for (int jt = 0; jt < 9; ++jt) { const int ki0 = qi0 + 16 * jt; const LAS bf16* kb = S0 + ((ki0 < 128) ? prvo : curo) + (ki0 & 127) * AKS + lk;
                sc[jt] = (f32x4){0.f, 0.f, 0.f, 0.f};
#pragma unroll
                for (int ks = 0; ks < 4; ++ks) sc[jt] = MFMA16(*(const LAS bf16x8*)(kb + 32 * ks), qf[ks], sc[jt]); }
            const float c0 = slope2 * (float)bd;
            float mx = -INFINITY;
            if (blk > 0) {
#pragma unroll
                for (int jt = 0; jt < 9; ++jt)
#pragma unroll
                    for (int rr = 0; rr < 4; ++rr) { float s = fmaf(sc[jt][rr], QK2, fmaf(slope2, (float)(16 * jt + rr), -c0));
                        if (jt == 0) s = (bd - rr <= 128) ? s : -INFINITY;
                        if (jt == 8) s = (bd - 128 - rr >= 0) ? s : -INFINITY;
                        sc[jt][rr] = s; mx = fmaxf(mx, s); }
            } else {
#pragma unroll
                for (int jt = 0; jt < 9; ++jt)
#pragma unroll
                    for (int rr = 0; rr < 4; ++rr) { const int diff = bd - (16 * jt + rr); const bool ok = (unsigned)diff <= (unsigned)(qi0 + li);
                        const float s = ok ? fmaf(sc[jt][rr], QK2, fmaf(slope2, (float)(16 * jt + rr), -c0)) : -INFINITY; sc[jt][rr] = s; mx = fmaxf(mx, s); }
            }
            mx = fmaxf(mx, __shfl_xor(mx, 16)); mx = fmaxf(mx, __shfl_xor(mx, 32));
            float z = 0.f;
#pragma unroll
            for (int jt = 0; jt < 9; ++jt)
#pragma unroll
                for (int rr = 0; rr < 4; ++rr) { const float p = __builtin_amdgcn_exp2f(sc[jt][rr] - mx); sc[jt][rr] = p; z += p; }
            z += __shfl_xor(z, 16); z += __shfl_xor(z, 32);
            f32x4 o[8];
#pragma unroll
            for (int vt = 0; vt < 8; ++vt) o[vt] = (f32x4){0.f, 0.f, 0.f, 0.f};
#pragma unroll
            for (int k2 = 0; k2 < 4; ++k2) { const f32x4 s0 = sc[2 * k2], s1 = sc[2 * k2 + 1];
                v4u pw; pw.x = pg8::cvt_pk_bf16(s0[0], s0[1]); pw.y = pg8::cvt_pk_bf16(s0[2], s0[3]); pw.z = pg8::cvt_pk_bf16(s1[0], s1[1]); pw.w = pg8::cvt_pk_bf16(s1[2], s1[3]);
                const bf16x8 pf = __builtin_bit_cast(bf16x8, pw);
                const int ka = qi0 + 32 * k2, kb2 = ka + 16;
                const LAS bf16* va = S0 + ((ka < 128) ? prvo : curo) + 128 * AKS + (ka & 127) * AKS + lv;
                const LAS bf16* vb = S0 + ((kb2 < 128) ? prvo : curo) + 128 * AKS + (kb2 & 127) * AKS + lv;
#pragma unroll
                for (int vt = 0; vt < 8; ++vt) o[vt] = MFMA16(cat8(TR16(va + 16 * vt), TR16(vb + 16 * vt)), pf, o[vt]); }
            {
                typedef unsigned u32x2v __attribute__((ext_vector_type(2)));
                u32x2v pw; pw.x = pg8::cvt_pk_bf16(sc[8][0], sc[8][1]); pw.y = pg8::cvt_pk_bf16(sc[8][2], sc[8][3]);
                const s16x4 pf4 = __builtin_bit_cast(s16x4, pw);
                const int ka = qi0 + 128; const LAS bf16* va = S0 + curo + 128 * AKS + (ka & 127) * AKS + lv;
#pragma unroll
                for (int vt = 0; vt < 8; ++vt) o[vt] = __builtin_amdgcn_mfma_f32_16x16x16bf16_1k(TR16(va + 16 * vt), pf4, o[vt], 0, 0, 0); }
            {
                float lnew = (mx + __builtin_amdgcn_logf(z)) * LN2, wn = 1.0f / z, wo = 0.f;
                if (MERGE) { const float lp = lpv; const float lq = lnew, mm = fmaxf(lp, lq); lnew = mm + __logf(__expf(lp - mm) + __expf(lq - mm)); wo = __expf(lp - lnew); wn = __expf(lq - lnew) / z; }
#pragma unroll
                for (int vt = 0; vt < 8; ++vt) { f32x4 val = o[vt] * wn;
                    if (MERGE) { const unsigned long long pv = yo[vt]; val[0] += wo * bflo((unsigned)pv); val[1] += wo * bfhi((unsigned)pv); val[2] += wo * bflo((unsigned)(pv >> 32)); val[3] += wo * bfhi((unsigned)(pv >> 32)); }
                    *(unsigned long long*)(yp + 16 * vt) = (unsigned long long)pg8::cvt_pk_bf16(val[0], val[1]) | ((unsigned long long)pg8::cvt_pk_bf16(val[2], val[3]) << 32); }
                if (g == 0) *lp_ = lnew; }
            __syncthreads();
            if (i + 1 < nblk) { attn_store_block(R, S0 + (par ^ 1) * ASLOT, tid); par ^= 1;
#pragma unroll
                for (int ks = 0; ks < 4; ++ks) qf[ks] = q8_to_bf16(qnr[ks]);
                __syncthreads(); }
        }
    }
}
__device__ __forceinline__ void attn_phase_a(Frame& F) {
    for (int u0 = F.vcu; u0 < 256; u0 += F.G) { const int bh = u0 >> 2, r4 = u0 & 3;
        for (int half = 0; half < 2; ++half) {
            attn_chain<1, false>(F, bh, r4, 4 * half, 4);
            asm volatile("s_waitcnt vmcnt(0)" ::: "memory"); __syncthreads();
            for (int k = 0; k < 4; ++k) attn_chain<0, true>(F, bh, r4 + 4 * k, half, 1); } }
}
__device__ __forceinline__ void attn_phase_b(Frame& F) {
    for (int u0 = F.vcu; u0 < 256; u0 += F.G) attn_chain<2, true>(F, u0 >> 2, 0, 8 * (u0 & 3), 8);
}
struct Args { const float* in[14]; float* out; unsigned char* ws; int ph_lo, ph_hi; };
__global__ void __launch_bounds__(NWAVES * 64, 2) mk_fwd(Args args) {
    extern __shared__ __attribute__((aligned(16))) unsigned char lds[];
    Frame F;
    F.lds = (LAS unsigned char*)lds;
    F.MISC = (volatile LAS unsigned*)(F.lds + MISC_OFF);
    F.tid = threadIdx.x; F.lane = F.tid & 63; F.wave = __builtin_amdgcn_readfirstlane(F.tid >> 6);
    F.G = gridDim.x; { const int bx = blockIdx.x; F.vcu = (F.G % 8 == 0) ? (bx % 8) * (F.G / 8) + bx / 8 : bx; }
    F.ws = args.ws; F.out = args.out; F.ctl = (gu32*)(args.ws + WS_CTL);
#pragma unroll
    for (int i = 0; i < 14; ++i) F.in[i] = args.in[i];
    for (int u = F.tid; u < (LDS_BYTES - LDSCTL_OFF) / 4; u += NWAVES * 64) ((LAS unsigned*)(F.lds + LDSCTL_OFF))[u] = 0u;
    __syncthreads();
#if MK_PER_PHASE
#define GRID_BAR() do { } while (0)
#else
    XcdBarrier bar = xcd_barrier_post((unsigned*)(F.ctl + CW_BAR), F.MISC + 8, F.wave);
#define GRID_BAR() xcd_barrier(bar)
#endif
    const int lo = args.ph_lo, hi = args.ph_hi;
#ifndef MK_PHASE_MASK
#define MK_PHASE_MASK 0xFFFF
#endif
#define IN(k) (((MK_PHASE_MASK >> (k)) & 1) && lo <= (k) && (k) < hi)
#define BOTH(k) (IN(k) && IN((k) + 1))
#ifndef MK_AMP_MASK
#define MK_AMP_MASK 0
#endif
#ifndef MK_AMP_X
#define MK_AMP_X 4
#endif
#define PH_T0() F.lane = pg8::fresh_lane(); F.tid = F.wave * 64 + F.lane; const unsigned long long _t0 = (MK_AMP_MASK != 0) ? rt() : 0ull
#define PH_AMP(k) do { if ((MK_AMP_MASK >> (k)) & 1) { const unsigned long long _t1 = rt(); while (rt() - _t1 < (unsigned long long)MK_AMP_X * (_t1 - _t0)) __builtin_amdgcn_s_sleep(8); } } while (0)
    bf16* const WA = (bf16*)(F.ws + WS_WA); bf16* const WAo = (bf16*)(F.ws + WS_WA + 24 * MiB);
    bf16* const ACT = (bf16*)(F.ws + WS_ACT); bf16* const Y = (bf16*)(F.ws + WS_Y); bf16* const PROJ = (bf16*)(F.ws + WS_PROJ); bf16* const HB = (bf16*)(F.ws + WS_H);
    unsigned long long* const SS = (unsigned long long*)(F.ws + WS_CTL + SS_OFF);
    const float* const x = F.in[0]; const float* const g_mix = F.in[1]; const float* const g_mlp = F.in[2];

    if (IN(0)) { PH_T0(); p0_prologue(F); PH_AMP(0); if (BOTH(0)) GRID_BAR(); }
    if (IN(1)) { PH_T0();
        glow_mfma(F);
        pg8::Gemm g{ACT, WA, M, NPROJ, D}; pg8::StaticOrder S; S.init(M, NPROJ, F.G, (int)blockIdx.x);
        pg8::EpiProj0 E{PROJ, NPROJ};
        pg8::gemm_phase<pg8::EpiProj0, pg8::StaticOrder, PG8_ALIGN, PG8_SP2>(F.lds + RING_OFF, g, S, E, F.wave);
        PH_AMP(1); if (BOTH(1)) GRID_BAR();
    }
    if (IN(2)) { PH_T0(); if (blockIdx.x & 1) { conv_set_a(F); __syncthreads(); gla_g1(F); } else { gla_g1(F); __syncthreads(); conv_set_a(F); } PH_AMP(2); if (BOTH(2)) GRID_BAR(); }
    if (IN(3)) { PH_T0(); gla_g2(F); conv_mix(F); PH_AMP(3); if (BOTH(3)) GRID_BAR(); }
    if (IN(4)) { PH_T0(); if (blockIdx.x & 1) { conv_set_b(F); __syncthreads(); gla_g3(F); } else { gla_g3(F); __syncthreads(); conv_set_b(F); } PH_AMP(4); if (BOTH(4)) GRID_BAR(); }
    if (IN(5)) { PH_T0();
        pg8::Gemm g{Y, WAo, M, D, D}; pg8::StaticOrder S; S.init(M, D, F.G, (int)blockIdx.x, 4);
        quant_rows_i8(F, (const bf16*)(F.ws + WS_WB), (unsigned char*)F.out + OUT_W8A, (const unsigned*)(F.ws + WS_CTL + CMAX0_OFF), FF, D);
        pg8::EpiRes2<true, 2> E{x, ACT, SS, D, (unsigned char*)F.out + OUT_X8A, (const unsigned long long*)(F.ws + WS_CTL + SSX_OFF), CLIP_X1};
        pg8::gemm_phase<pg8::EpiRes2<true, 2>, pg8::StaticOrder, PG8_ALIGN, PG8_SP2>(F.lds + RING_OFF, g, S, E, F.wave);
        PH_AMP(5); if (BOTH(5)) GRID_BAR();
    }
    if (IN(6)) { PH_T0();
        pg8::Gemm g{(const bf16*)((unsigned char*)F.out + OUT_X8A), (const bf16*)((unsigned char*)F.out + OUT_W8A), M, FF, D}; pg8::StaticOrder S; S.init(M, FF, F.G, (int)blockIdx.x, 4, 1);
        pg8::EpiI8<1> E{HB, FF, SS, (const unsigned long long*)(F.ws + WS_CTL + SSX_OFF), (const unsigned*)(F.ws + WS_CTL + CMAX0_OFF), CLIP_X1};
        pg8::gemm_phase<pg8::EpiI8<1>, pg8::StaticOrder, PG8_ALIGN, PG8_SP2, 2>(F.lds + RING_OFF, g, S, E, F.wave);
        PH_AMP(6); if (BOTH(6)) GRID_BAR();
    }
    if (IN(7)) { PH_T0();
        pg8::Gemm g{HB, (bf16*)(F.ws + WS_WB + 32 * MiB), M, D, FF}; pg8::StaticOrder S; S.init(M, D, F.G, (int)blockIdx.x, 4);
        quant_rows_i8(F, WA, (unsigned char*)F.out + OUT_WQ8, (const unsigned*)(F.ws + WS_CTL + CMAXQ_OFF), NPROJ, D);
        pg8::EpiRes2<false, 2> E{ACT, ACT, SS + M, D, F.ws + WS_A8, SS, CLIP_X2};
        pg8::gemm_phase<pg8::EpiRes2<false, 2>, pg8::StaticOrder, PG8_ALIGN, PG8_SP2>(F.lds + RING_OFF, g, S, E, F.wave);
        PH_AMP(7); if (BOTH(7)) GRID_BAR();
    }
    if (IN(8)) { PH_T0();
        pg8::Gemm g{(const bf16*)(F.ws + WS_A8), (const bf16*)((unsigned char*)F.out + OUT_WQ8), M, NPROJ, D}; pg8::StaticOrder S; S.init(M, NPROJ, F.G, (int)blockIdx.x, 4);
        pg8::EpiQkvI8 E{F.ws + WS_PROJ, SS + M, SS, (const unsigned*)(F.ws + WS_CTL + CMAXQ_OFF), CLIP_X2};
        pg8::gemm_phase<pg8::EpiQkvI8, pg8::StaticOrder, PG8_ALIGN, PG8_SP2, 2>(F.lds + RING_OFF, g, S, E, F.wave);
        PH_AMP(8); if (BOTH(8)) GRID_BAR();
    }
    if (IN(9)) { PH_T0(); attn_phase_a(F); PH_AMP(9); if (BOTH(9)) GRID_BAR(); }
    if (IN(11)) { PH_T0(); attn_phase_b(F); PH_AMP(11); if (BOTH(11)) GRID_BAR(); }
    if (IN(12)) { PH_T0();
        pg8::Gemm g{Y, (const bf16*)((unsigned char*)F.out + OUT_WO), M, D, D}; pg8::StaticOrder S; S.init(M, D, F.G, (int)blockIdx.x, 4);
        quant_rows_i8(F, (const bf16*)(F.ws + WS_WC), F.ws + WS_W8, (const unsigned*)(F.ws + WS_CTL + CMAX1_OFF), FF, D);
        pg8::EpiRes2<false, 2> E{ACT, ACT, SS + 2 * M, D, F.ws + WS_X8, SS + M};
        pg8::gemm_phase<pg8::EpiRes2<false, 2>, pg8::StaticOrder, PG8_ALIGN, PG8_SP2>(F.lds + RING_OFF, g, S, E, F.wave);
        PH_AMP(12); if (BOTH(12)) GRID_BAR();
    }
    if (IN(13)) { PH_T0();
        pg8::Gemm g{(const bf16*)(F.ws + WS_X8), (const bf16*)(F.ws + WS_W8), M, FF, D}; pg8::StaticOrder S; S.init(M, FF, F.G, (int)blockIdx.x, 4, 1);
        pg8::EpiI8<1> E{HB, FF, SS + 2 * M, SS + M, (const unsigned*)(F.ws + WS_CTL + CMAX1_OFF)};
        pg8::gemm_phase<pg8::EpiI8<1>, pg8::StaticOrder, PG8_ALIGN, PG8_SP2, 2>(F.lds + RING_OFF, g, S, E, F.wave);
        PH_AMP(13); if (BOTH(13)) GRID_BAR();
    }
    if (IN(14)) { PH_T0();
        pg8::Gemm g{HB, (bf16*)(F.ws + WS_WC + 32 * MiB), M, D, FF}; pg8::StaticOrder S; S.init(M, D, F.G, (int)blockIdx.x, 4);
        pg8::EpiFinal E{ACT, F.out, F.in[3], SS, (unsigned*)(F.ws + WS_CTL + FCNT_OFF), D};
        E.ss = SS + 3 * (size_t)M;
        pg8::gemm_phase<pg8::EpiFinal, pg8::StaticOrder, PG8_ALIGN, PG8_SP2>(F.lds + RING_OFF, g, S, E, F.wave);
        PH_AMP(14);
    }
#undef IN
#undef BOTH
}

extern "C" void kernel_launch(void* const* d_in, const int* in_sizes, int n_in, void* d_out, int out_size, void* d_ws, size_t ws_size, hipStream_t stream) {
    static int grid = 0;
    if (grid == 0) {
        if (n_in != 14 || in_sizes[0] != M * D || out_size != M * D || ws_size < WS_END) { fprintf(stderr, "kernel_launch: unexpected shapes (n_in %d, in0 %d, out %d, ws %zu); nothing launched\n", n_in, n_in > 0 ? in_sizes[0] : -1, out_size, ws_size); grid = -1; return; }
        int dev = 0, cus = 0, per_cu = 0;
        if (hipGetDevice(&dev) != hipSuccess || hipDeviceGetAttribute(&cus, hipDeviceAttributeMultiprocessorCount, dev) != hipSuccess) { grid = -1; return; }
        if (hipFuncSetAttribute((const void*)mk_fwd, hipFuncAttributeMaxDynamicSharedMemorySize, LDS_BYTES) != hipSuccess) { fprintf(stderr, "kernel_launch: hipFuncSetAttribute failed\n"); grid = -1; return; }
        if (hipOccupancyMaxActiveBlocksPerMultiprocessor(&per_cu, (const void*)mk_fwd, NWAVES * 64, LDS_BYTES) != hipSuccess || per_cu < 1) { fprintf(stderr, "kernel_launch: occupancy query says %d\n", per_cu); }
        (void)hipGetLastError();
        grid = cus;
    }
    if (grid < 0) return;
    if (hipMemsetAsync((char*)d_ws + WS_CTL, 0, CTL_ZERO_BYTES, stream) != hipSuccess) return;
    Args a{};
    for (int i = 0; i < 14; ++i) a.in[i] = (const float*)d_in[i];
    a.out = (float*)d_out; a.ws = (unsigned char*)d_ws;
#if MK_PER_PHASE
    for (int p = 0; p < NPHASE; ++p) { a.ph_lo = p; a.ph_hi = p + 1; hipLaunchKernelGGL(mk_fwd, dim3(grid), dim3(NWAVES * 64), LDS_BYTES, stream, a); }
#else
    a.ph_lo = 0; a.ph_hi = NPHASE; hipLaunchKernelGGL(mk_fwd, dim3(grid), dim3(NWAVES * 64), LDS_BYTES, stream, a);
#endif
}
```

```cpp
#include <hip/hip_runtime.h>
#include <cstdio>
#include <cstdint>
#include <cmath>
namespace pg8 {
#define PG8_LAS __attribute__((address_space(3)))
typedef unsigned short bf16_t;
typedef short bf16x8 __attribute__((ext_vector_type(8)));
typedef float f32x4 __attribute__((ext_vector_type(4)));
typedef unsigned u32x4 __attribute__((ext_vector_type(4)));
typedef int i32x4 __attribute__((ext_vector_type(4)));
__device__ __forceinline__ int fresh_lane() { unsigned z = 0u; asm volatile("" : "+s"(z)); return (int)__builtin_amdgcn_mbcnt_hi(~0u, __builtin_amdgcn_mbcnt_lo(~0u, z)); }
constexpr int BM = 256, BK = 64, HALF = 128, HTB = HALF * BK * 2  , STAGE_BYTES = 8 * HTB, NXCD = 8, WGM = 8;

__host__ __device__ __forceinline__ int lds_byte(int r, int c) { const int st = (r >> 4) * 2 + (c >> 5), rr = r & 15, cc = c & 31, ob = rr * 64 + cc * 2; return st * 1024 + (ob ^ (((ob >> 9) & 1) << 5)); }
__host__ __device__ __forceinline__ void stage_rc(int b, int& R, int& C) { const int st = b / 1024, sb = b % 1024, swz = sb ^ (((sb >> 9) & 1) << 5); R = (st >> 1) * 16 + swz / 64; C = (st & 1) * 32 + (swz % 64) / 2; }
__host__ __device__ __forceinline__ int perm32(int rho) { const int n = rho >> 4, i = rho & 15; return 8 * (i >> 2) + 4 * n + (i & 3); }

struct Unit { int pm, pn; };
struct Gemm { const bf16_t* A; const bf16_t* Bt; int M, N, K; };

struct StaticOrder {
    int nM, nN, nwg, G, c, wgm, revn;
    __host__ __device__ void init(int M, int N, int G_, int c_, int wgm_ = WGM, int revn_ = 0) { nM = M / BM; nN = N / BM; nwg = nM * nN; G = G_; c = c_; wgm = wgm_; revn = revn_; }
    __host__ __device__ bool next(int i, Unit& u) const {
        const long L = (long)i * G + c; if (L >= nwg) return false;
        int wgid = (int)L; { const int q = nwg / NXCD, r = nwg % NXCD, xcd = wgid % NXCD, off = wgid / NXCD; wgid = (xcd < r ? xcd * (q + 1) : r * (q + 1) + (xcd - r) * q) + off; }
        const int nig = wgm * nN, gid = wgid / nig, fm = gid * wgm, gsz = (nM - fm) < wgm ? (nM - fm) : wgm;
        u.pm = fm + ((wgid % nig) % gsz); u.pn = (wgid % nig) / gsz; if (revn) u.pn = nN - 1 - u.pn; return true;
    }
    __device__ __forceinline__ void a_ready(const Unit&) const {}
    __device__ __forceinline__ void done(const Unit&) const {}
};
__device__ __forceinline__ unsigned cvt_pk_bf16(float lo, float hi) { unsigned r; asm volatile("v_cvt_pk_bf16_f32 %0, %1, %2" : "=v"(r) : "v"(lo), "v"(hi)); return r; }
typedef unsigned u32x2 __attribute__((ext_vector_type(2)));
constexpr float RMS_EPS = 1e-6f, INV_D = 1.0f / 2048.0f;

template <int MODE> struct EpiBf16S {
    static constexpr bool PERM = true, AFTER_DRAIN = false, HAS_PRE = false; struct Pre {};
    bf16_t* O; int ldc; const unsigned long long* ss; float mul = 1.0f;
    __device__ __forceinline__ void operator()(const f32x4 (&acc)[2][2][4][2], const Unit& u, int wr, int wc, int fr, int fq) const {
        const int row0 = u.pm * BM + wr * 64 + fr, col0 = u.pn * BM + wc * 32 + 8 * fq;
#pragma unroll
        for (int ai = 0; ai < 2; ++ai)
#pragma unroll
            for (int m = 0; m < 4; ++m) { const int row = row0 + ai * HALF + m * 16; bf16_t* rowp = O + (size_t)row * ldc + col0;
                float sc = mul; if (ss) sc = mul * __builtin_amdgcn_rsqf((float)ss[row] * (INV_D / 1048576.0f) + RMS_EPS);
#pragma unroll
                for (int bj = 0; bj < 2; ++bj) { f32x4 v0 = acc[ai][bj][m][0], v1 = acc[ai][bj][m][1];
                    if (MODE == 1) {
#pragma unroll
                        for (int j = 0; j < 4; ++j) { float a = fmaxf(v0[j], 0.f) * sc, b = fmaxf(v1[j], 0.f) * sc; v0[j] = a * a; v1[j] = b * b; } }
                    else { v0 = v0 * sc; v1 = v1 * sc; }
                    u32x4 w; w.x = cvt_pk_bf16(v0[0], v0[1]); w.y = cvt_pk_bf16(v0[2], v0[3]); w.z = cvt_pk_bf16(v1[0], v1[1]); w.w = cvt_pk_bf16(v1[2], v1[3]);
                    *(u32x4*)(rowp + bj * HALF) = w; } }
    }
};
struct EpiProj0 {
    static constexpr bool PERM = true, AFTER_DRAIN = false, HAS_PRE = false; struct Pre {};
    bf16_t* O; int ldc;
    __device__ __forceinline__ void operator()(const f32x4 (&acc)[2][2][4][2], const Unit& u, int wr, int wc, int fr, int fq) const {
        const int row0 = u.pm * BM + wr * 64 + fr; const bool prod = (u.pn >= 4) && (u.pn < 12);
        const int col0 = prod ? (1024 + (u.pn - 4) * HALF + wc * 32 + 8 * fq) : (u.pn * BM + wc * 32 + 8 * fq);
#pragma unroll
        for (int ai = 0; ai < 2; ++ai)
#pragma unroll
            for (int m = 0; m < 4; ++m) { bf16_t* rowp = O + (size_t)(row0 + ai * HALF + m * 16) * ldc + col0;
                if (prod) { const f32x4 v0 = acc[ai][0][m][0] * acc[ai][1][m][0], v1 = acc[ai][0][m][1] * acc[ai][1][m][1];
                    u32x4 w; w.x = cvt_pk_bf16(v0[0], v0[1]); w.y = cvt_pk_bf16(v0[2], v0[3]); w.z = cvt_pk_bf16(v1[0], v1[1]); w.w = cvt_pk_bf16(v1[2], v1[3]);
                    *(u32x4*)rowp = w; }
                else {
#pragma unroll
                    for (int bj = 0; bj < 2; ++bj) { const f32x4 v0 = acc[ai][bj][m][0], v1 = acc[ai][bj][m][1];
                        u32x4 w; w.x = cvt_pk_bf16(v0[0], v0[1]); w.y = cvt_pk_bf16(v0[2], v0[3]); w.z = cvt_pk_bf16(v1[0], v1[1]); w.w = cvt_pk_bf16(v1[2], v1[3]);
                        *(u32x4*)(rowp + bj * HALF) = w; } } }
    }
};
__device__ __forceinline__ unsigned pk4_fp8(float a, float b, float c, float d) { int w = __builtin_amdgcn_cvt_pk_fp8_f32(a, b, 0, false); w = __builtin_amdgcn_cvt_pk_fp8_f32(c, d, w, true); return (unsigned)w; }
constexpr float Q8_CLIP = 4.6f;
__device__ __forceinline__ float rowq_inv(unsigned long long ssv, float clip) { return clip * (1.0f / 127.0f) * __builtin_sqrtf((float)ssv * (INV_D / 1048576.0f) + RMS_EPS); }
__device__ __forceinline__ unsigned qbyte(float x) { const float t = __builtin_fmaxf(__builtin_fminf(x, 127.f), -127.f); return __builtin_bit_cast(unsigned, t + 12582912.f); }
__device__ __forceinline__ unsigned pk4_i8(float a, float b, float c, float d) { return (qbyte(a) & 0xffu) | ((qbyte(b) & 0xffu) << 8) | ((qbyte(c) & 0xffu) << 16) | (qbyte(d) << 24); }
template <bool BASE_F32, int W8 = 0> struct EpiRes2 {
    static constexpr bool PERM = true, AFTER_DRAIN = false, HAS_PRE = false; struct Pre {};
    const void* base; bf16_t* O; unsigned long long* ss; int ldc; unsigned char* O8 = nullptr; const unsigned long long* qs = nullptr; float qclip = Q8_CLIP;
#define EPIRES2_ROW(ai, m, B0, B1) do { const int row = row0 + (ai) * HALF + (m) * 16; const size_t off = (size_t)row * ldc + col0; float s = 0.f; \
        float sq = 0.f; if constexpr (W8 == 2) sq = __builtin_amdgcn_rcpf(rowq_inv(qv[(ai) * 4 + (m)], qclip)); \
        _Pragma("unroll") for (int bj = 0; bj < 2; ++bj) { f32x4 v0 = acc[ai][bj][m][0], v1 = acc[ai][bj][m][1]; \
            if constexpr (BASE_F32) { v0 = v0 + __builtin_bit_cast(f32x4, B0[bj]); v1 = v1 + __builtin_bit_cast(f32x4, B1[bj]); } \
            else { const u32x4 b = __builtin_bit_cast(u32x4, B0[bj]); \
                v0[0] += __uint_as_float(b.x << 16); v0[1] += __uint_as_float(b.x & 0xffff0000u); v0[2] += __uint_as_float(b.y << 16); v0[3] += __uint_as_float(b.y & 0xffff0000u); \
                v1[0] += __uint_as_float(b.z << 16); v1[1] += __uint_as_float(b.z & 0xffff0000u); v1[2] += __uint_as_float(b.w << 16); v1[3] += __uint_as_float(b.w & 0xffff0000u); } \
            s += ((v0[0] * v0[0] + v0[1] * v0[1]) + (v0[2] * v0[2] + v0[3] * v0[3])) + ((v1[0] * v1[0] + v1[1] * v1[1]) + (v1[2] * v1[2] + v1[3] * v1[3])); \
            u32x4 w; w.x = cvt_pk_bf16(v0[0], v0[1]); w.y = cvt_pk_bf16(v0[2], v0[3]); w.z = cvt_pk_bf16(v1[0], v1[1]); w.w = cvt_pk_bf16(v1[2], v1[3]); \
            *(u32x4*)(O + off + bj * HALF) = w; \
            if constexpr (W8 == 1) { u32x2 w8; w8.x = pk4_fp8(v0[0], v0[1], v0[2], v0[3]); w8.y = pk4_fp8(v1[0], v1[1], v1[2], v1[3]); *(u32x2*)(O8 + off + bj * HALF) = w8; } \
            if constexpr (W8 == 2) { u32x2 w8; w8.x = pk4_i8(v0[0] * sq, v0[1] * sq, v0[2] * sq, v0[3] * sq); w8.y = pk4_i8(v1[0] * sq, v1[1] * sq, v1[2] * sq, v1[3] * sq); *(u32x2*)(O8 + off + bj * HALF) = w8; } } \
        s += __shfl_xor(s, 16); s += __shfl_xor(s, 32); sv[(ai) * 4 + (m)] = s; } while (0)
    __device__ __forceinline__ void operator()(const f32x4 (&acc)[2][2][4][2], const Unit& u, int wr, int wc, int fr, int fq) const {
        const int row0 = u.pm * BM + wr * 64 + fr, col0 = u.pn * BM + wc * 32 + 8 * fq;
        float sv[8]; unsigned long long qv[8];
        if constexpr (W8 == 2) {
#pragma unroll
            for (int r = 0; r < 8; ++r) qv[r] = qs[row0 + (r >> 2) * HALF + (r & 3) * 16]; }
        if constexpr (!BASE_F32) {
#pragma unroll
            for (int ai = 0; ai < 2; ++ai) { u32x4 bb[4][2];
#pragma unroll
                for (int m = 0; m < 4; ++m)
#pragma unroll
                    for (int bj = 0; bj < 2; ++bj) bb[m][bj] = *(const u32x4*)((const bf16_t*)base + (size_t)(row0 + ai * HALF + m * 16) * ldc + col0 + bj * HALF);
                asm volatile("" ::: "memory");
#pragma unroll
                for (int m = 0; m < 4; ++m) EPIRES2_ROW(ai, m, bb[m], bb[m]);
                asm volatile("" ::: "memory"); }
        } else {
#pragma unroll
            for (int q = 0; q < 4; ++q) { const int ai = q >> 1; f32x4 b0[2][2], b1[2][2];
#pragma unroll
                for (int mm = 0; mm < 2; ++mm)
#pragma unroll
                    for (int bj = 0; bj < 2; ++bj) { const float* bp = (const float*)base + (size_t)(row0 + ai * HALF + (2 * (q & 1) + mm) * 16) * ldc + col0 + bj * HALF; b0[mm][bj] = *(const f32x4*)bp; b1[mm][bj] = *(const f32x4*)(bp + 4); }
                asm volatile("" ::: "memory");
#pragma unroll
                for (int mm = 0; mm < 2; ++mm) { if (q == 0) { EPIRES2_ROW(0, mm, b0[mm], b1[mm]); } else if (q == 1) { EPIRES2_ROW(0, 2 + mm, b0[mm], b1[mm]); } else if (q == 2) { EPIRES2_ROW(1, mm, b0[mm], b1[mm]); } else { EPIRES2_ROW(1, 2 + mm, b0[mm], b1[mm]); } }
                asm volatile("" ::: "memory"); }
        }
#undef EPIRES2_ROW
        if (ss) {
#pragma unroll
            for (int hh = 0; hh < 2; ++hh) { float v = sv[4 * hh];
#pragma unroll
                for (int q = 1; q < 4; ++q) v = (fq == q) ? sv[4 * hh + q] : v;
                atomicAdd(ss + row0 + hh * HALF + fq * 16, (unsigned long long)(v * 1048576.0f + 0.5f)); } }
    }
};

template <int MODE> struct EpiI8 {
    static constexpr bool PERM = true, AFTER_DRAIN = false, HAS_PRE = true; struct Pre { u32x4 c[4]; };
    bf16_t* O; int ldc; const PG8_LAS float* rft; int pmA; const unsigned* cmax;
    __device__ __forceinline__ void pre(const Unit& u, int wc, int fq, Pre& p) const { const unsigned* cp = cmax + u.pn * BM + wc * 32 + 8 * fq;
        p.c[0] = *(const u32x4*)cp; p.c[1] = *(const u32x4*)(cp + 4); p.c[2] = *(const u32x4*)(cp + HALF); p.c[3] = *(const u32x4*)(cp + HALF + 4); }
    __device__ __forceinline__ void operator()(const f32x4 (&acc)[2][2][4][2], const Unit& u, int wr, int wc, int fr, int fq, const Pre& p) const {
        const int row0 = u.pm * BM + wr * 64 + fr, col0 = u.pn * BM + wc * 32 + 8 * fq;
        f32x4 cf[2][2];
#pragma unroll
        for (int bj = 0; bj < 2; ++bj)
#pragma unroll
            for (int n = 0; n < 2; ++n) { const u32x4 c = p.c[2 * bj + n];
                cf[bj][n] = (f32x4){__uint_as_float(c.x), __uint_as_float(c.y), __uint_as_float(c.z), __uint_as_float(c.w)} * (1.0f / 127.0f); }
        const PG8_LAS float* rt = rft + ((u.pm == pmA) ? 0 : 256) + wr * 64 + fr;
        float rfv[8];
#pragma unroll
        for (int r = 0; r < 8; ++r) rfv[r] = rt[(r >> 2) * HALF + (r & 3) * 16];
#pragma unroll
        for (int ai = 0; ai < 2; ++ai)
#pragma unroll
            for (int m = 0; m < 4; ++m) { const int row = row0 + ai * HALF + m * 16; bf16_t* rowp = O + (size_t)row * ldc + col0;
                const float rf = rfv[ai * 4 + m];
#pragma unroll
                for (int bj = 0; bj < 2; ++bj) { const i32x4 a0 = __builtin_bit_cast(i32x4, acc[ai][bj][m][0]), a1 = __builtin_bit_cast(i32x4, acc[ai][bj][m][1]); f32x4 v0, v1;
#pragma unroll
                    for (int j = 0; j < 4; ++j) { if (MODE == 1) { const float x = fmaxf((float)a0[j] * cf[bj][0][j], 0.f) * rf, y = fmaxf((float)a1[j] * cf[bj][1][j], 0.f) * rf; v0[j] = x * x; v1[j] = y * y; }
                        else { v0[j] = (float)a0[j] * cf[bj][0][j] * rf; v1[j] = (float)a1[j] * cf[bj][1][j] * rf; } }
                    u32x4 w; w.x = cvt_pk_bf16(v0[0], v0[1]); w.y = cvt_pk_bf16(v0[2], v0[3]); w.z = cvt_pk_bf16(v1[0], v1[1]); w.w = cvt_pk_bf16(v1[2], v1[3]);
                    *(u32x4*)(rowp + bj * HALF) = w; } }
    }
};

struct EpiQkvI8 {
    static constexpr bool PERM = true, AFTER_DRAIN = false, HAS_PRE = true; struct Pre { u32x4 c[4]; };
    unsigned char* QKV; const PG8_LAS float* rft; int pmA; const unsigned* cmax;
    __device__ __forceinline__ void pre(const Unit& u, int wc, int fq, Pre& p) const { const unsigned* cp = cmax + u.pn * BM + wc * 32 + 8 * fq;
        p.c[0] = *(const u32x4*)cp; p.c[1] = *(const u32x4*)(cp + 4); p.c[2] = *(const u32x4*)(cp + HALF); p.c[3] = *(const u32x4*)(cp + HALF + 4); }
    __device__ __forceinline__ void operator()(const f32x4 (&acc)[2][2][4][2], const Unit& u, int wr, int wc, int fr, int fq, const Pre& p) const {
        const int row0 = u.pm * BM + wr * 64 + fr, col0 = u.pn * BM + wc * 32 + 8 * fq;
        f32x4 cf[2][2];
#pragma unroll
        for (int bj = 0; bj < 2; ++bj)
#pragma unroll
            for (int n = 0; n < 2; ++n) { const u32x4 c = p.c[2 * bj + n];
                cf[bj][n] = (f32x4){__uint_as_float(c.x), __uint_as_float(c.y), __uint_as_float(c.z), __uint_as_float(c.w)} * (1.0f / 127.0f); }
        const PG8_LAS float* rt = rft + ((u.pm == pmA) ? 0 : 256) + wr * 64 + fr;
        float rfv[8];
#pragma unroll
        for (int r = 0; r < 8; ++r) rfv[r] = rt[(r >> 2) * HALF + (r & 3) * 16];
#pragma unroll
        for (int ai = 0; ai < 2; ++ai)
#pragma unroll
            for (int m = 0; m < 4; ++m) { const int row = row0 + ai * HALF + m * 16;
                const float rf = rfv[ai * 4 + m];
#pragma unroll
                for (int bj = 0; bj < 2; ++bj) { const i32x4 a0 = __builtin_bit_cast(i32x4, acc[ai][bj][m][0]), a1 = __builtin_bit_cast(i32x4, acc[ai][bj][m][1]); f32x4 v0, v1;
#pragma unroll
                    for (int j = 0; j < 4; ++j) { v0[j] = (float)a0[j] * cf[bj][0][j] * rf; v1[j] = (float)a1[j] * cf[bj][1][j] * rf; }
                    u32x2 w8; w8.x = pk4_fp8(v0[0], v0[1], v0[2], v0[3]); w8.y = pk4_fp8(v1[0], v1[1], v1[2], v1[3]);
                    *(u32x2*)(QKV + (size_t)row * 6144 + col0 + bj * HALF) = w8; } }
    }
};

struct EpiFinal {
    static constexpr bool PERM = true, AFTER_DRAIN = false, HAS_PRE = false; struct Pre {};
    const bf16_t* base; float* out; const float* g; unsigned long long* ss; unsigned* cnt; int ldc;
    __device__ __forceinline__ void operator()(f32x4 (&acc)[2][2][4][2], const Unit& u, int wr, int wc, int fr, int fq) const {
        const int row0 = u.pm * BM + wr * 64 + fr, col0 = u.pn * BM + wc * 32 + 8 * fq;
        float sv[8];
#pragma unroll
        for (int ai = 0; ai < 2; ++ai)
#pragma unroll
            for (int m = 0; m < 4; ++m) { const int row = row0 + ai * HALF + m * 16; const size_t off = (size_t)row * ldc + col0; float s = 0.f;
#pragma unroll
                for (int bj = 0; bj < 2; ++bj) { f32x4 v0 = acc[ai][bj][m][0], v1 = acc[ai][bj][m][1];
                    const u32x4 b = *(const u32x4*)(base + off + bj * HALF);
                    v0[0] += __uint_as_float(b.x << 16); v0[1] += __uint_as_float(b.x & 0xffff0000u); v0[2] += __uint_as_float(b.y << 16); v0[3] += __uint_as_float(b.y & 0xffff0000u);
                    v1[0] += __uint_as_float(b.z << 16); v1[1] += __uint_as_float(b.z & 0xffff0000u); v1[2] += __uint_as_float(b.w << 16); v1[3] += __uint_as_float(b.w & 0xffff0000u);
                    s += ((v0[0] * v0[0] + v0[1] * v0[1]) + (v0[2] * v0[2] + v0[3] * v0[3])) + ((v1[0] * v1[0] + v1[1] * v1[1]) + (v1[2] * v1[2] + v1[3] * v1[3]));
                    acc[ai][bj][m][0] = v0; acc[ai][bj][m][1] = v1; }
                s += __shfl_xor(s, 16); s += __shfl_xor(s, 32); sv[ai * 4 + m] = s; }
#pragma unroll
        for (int hh = 0; hh < 2; ++hh) { float v = sv[4 * hh];
#pragma unroll
            for (int q = 1; q < 4; ++q) v = (fq == q) ? sv[4 * hh + q] : v;
            atomicAdd(ss + row0 + hh * HALF + fq * 16, (unsigned long long)(v * 1048576.0f + 0.5f)); }
        f32x4 gv[2][2];
#pragma unroll
        for (int bj = 0; bj < 2; ++bj) { gv[bj][0] = *(const f32x4*)(g + col0 + bj * HALF); gv[bj][1] = *(const f32x4*)(g + col0 + bj * HALF + 4); }
        asm volatile("s_waitcnt vmcnt(0)" ::: "memory");
        unsigned* c = cnt + 64 * u.pm;
        if ((fr | fq) == 0) __hip_atomic_fetch_add(c, 1u, __ATOMIC_RELAXED, __HIP_MEMORY_SCOPE_AGENT);
        { unsigned spins = 0; const unsigned want = 64u;
          while ((unsigned)__builtin_amdgcn_readfirstlane(__hip_atomic_load(c, __ATOMIC_RELAXED, __HIP_MEMORY_SCOPE_AGENT)) < want) { __builtin_amdgcn_s_sleep(2); if (++spins > (1u << 22)) break; } }
        unsigned long long sqn = __hip_atomic_load(ss + row0, __ATOMIC_RELAXED, __HIP_MEMORY_SCOPE_AGENT);
#pragma unroll
        for (int r = 0; r < 8; ++r) { const int ai = r >> 2, m = r & 3; const int row = row0 + ai * HALF + m * 16; const size_t off = (size_t)row * ldc + col0;
            const unsigned long long sq = sqn;
            if (r + 1 < 8) sqn = __hip_atomic_load(ss + row0 + ((r + 1) >> 2) * HALF + ((r + 1) & 3) * 16, __ATOMIC_RELAXED, __HIP_MEMORY_SCOPE_AGENT);
            const float sc = __builtin_amdgcn_rsqf((float)sq * (INV_D / 1048576.0f) + RMS_EPS);
            asm volatile("" ::: "memory");
#pragma unroll
            for (int bj = 0; bj < 2; ++bj) { *(f32x4*)(out + off + bj * HALF) = acc[ai][bj][m][0] * gv[bj][0] * sc; *(f32x4*)(out + off + bj * HALF + 4) = acc[ai][bj][m][1] * gv[bj][1] * sc; } }
    }
};

template <class Epi, class Sched, bool ALIGN_EPI = false, bool SP2 = false, int NUM = 0>
__device__ __forceinline__ void gemm_phase(PG8_LAS unsigned char* lds, const Gemm g, const Sched& S, const Epi& E, const int wid  ) {
    constexpr bool F8 = (NUM == 1), I8 = (NUM == 2);
    const int lane = fresh_lane(), tid = wid * 64 + lane, wr = wid >> 2, wc = wid & 3, fr = lane & 15, fq = lane >> 4;
    const int K = (NUM != 0) ? g.K / 2 : g.K, nt = K / BK;
    unsigned voffA[2], voffB[2];
#pragma unroll
    for (int i = 0; i < 2; ++i) { int R, C; stage_rc(tid * 16 + i * 8192, R, C); const int Rb = Epi::PERM ? ((R & ~31) + perm32(R & 31)) : R;
        voffA[i] = (unsigned)(R * K + C) * 2u; voffB[i] = (unsigned)(Rb * K + C) * 2u; }
    const size_t kstep = (size_t)(BK * 2);
    const size_t hstep = (size_t)HALF * K * 2;
    const size_t tstep = 2 * hstep;
    const unsigned ldsw = (unsigned)wid * 1024u;
    const int aoff = lds_byte(wr * 64 + fr, fq * 8), boff = lds_byte(wc * 32 + fr, fq * 8);
#define PG8_SA(b, h) (((b) * 2 + (h)) * HTB)
#define PG8_SB(b, h) ((4 + (b) * 2 + (h)) * HTB)
#define PG8_STAGE(bufoff, gbase, voff) do { _Pragma("unroll") for (int _i = 0; _i < 2; ++_i) { unsigned _vo = (voff)[_i]; asm volatile("" : "+v"(_vo)); \
        __builtin_amdgcn_global_load_lds((const unsigned*)((const char*)(gbase) + _vo), (PG8_LAS unsigned*)(lds + (bufoff) + ldsw + _i * 8192), 16, 0, 0); } } while (0)
#define PG8_LDA(dst, b, h) do { _Pragma("unroll") for (int m = 0; m < 4; ++m) _Pragma("unroll") for (int k = 0; k < 2; ++k) dst[m][k] = *(const PG8_LAS bf16x8*)(lds + PG8_SA(b, h) + aoff + m * 2048 + k * 1024); } while (0)
#define PG8_LDB(dst, b, h) do { _Pragma("unroll") for (int n = 0; n < 2; ++n) _Pragma("unroll") for (int k = 0; k < 2; ++k) dst[n][k] = *(const PG8_LAS bf16x8*)(lds + PG8_SB(b, h) + boff + n * 2048 + k * 1024); } while (0)
#define PG8_CAT8(x) __builtin_shufflevector(__builtin_bit_cast(i32x4, (x)[0]), __builtin_bit_cast(i32x4, (x)[1]), 0, 1, 2, 3, 4, 5, 6, 7)
#define PG8_MMA(ai, bj, At, Bt) do { __builtin_amdgcn_s_setprio(3); _Pragma("unroll") for (int m = 0; m < 4; ++m) _Pragma("unroll") for (int n = 0; n < 2; ++n) { \
        if constexpr (F8) acc[ai][bj][m][n] = __builtin_amdgcn_mfma_scale_f32_16x16x128_f8f6f4(PG8_CAT8(Bt[n]), PG8_CAT8(At[m]), acc[ai][bj][m][n], 0, 0, 0, 0, 0, 0); \
        else if constexpr (I8) { _Pragma("unroll") for (int k = 0; k < 2; ++k) acc[ai][bj][m][n] = __builtin_bit_cast(f32x4, __builtin_amdgcn_mfma_i32_16x16x64_i8(__builtin_bit_cast(i32x4, Bt[n][k]), __builtin_bit_cast(i32x4, At[m][k]), __builtin_bit_cast(i32x4, acc[ai][bj][m][n]), 0, 0, 0)); } \
        else { _Pragma("unroll") for (int k = 0; k < 2; ++k) acc[ai][bj][m][n] = __builtin_amdgcn_mfma_f32_16x16x32_bf16(Bt[n][k], At[m][k], acc[ai][bj][m][n], 0, 0, 0); } } __builtin_amdgcn_s_setprio(0); } while (0)
#define PG8_WAIT_V(n) asm volatile("s_waitcnt vmcnt(" #n ")" ::: "memory")
#define PG8_WAIT_L(n) asm volatile("s_waitcnt lgkmcnt(" #n ")" ::: "memory")
#define PG8_BAR __builtin_amdgcn_s_barrier()
#define PG8_SCHED __builtin_amdgcn_sched_barrier(0)
    Unit cur, nxt; int ui = 0; typename Epi::Pre pre{};
    if (!S.next(0, cur)) return;
    f32x4 acc[2][2][4][2];
#pragma unroll
    for (int a = 0; a < 2; ++a)
#pragma unroll
        for (int b = 0; b < 2; ++b)
#pragma unroll
            for (int m = 0; m < 4; ++m)
#pragma unroll
                for (int n = 0; n < 2; ++n) acc[a][b][m][n] = (f32x4){0.f, 0.f, 0.f, 0.f};
    bf16x8 At[4][2], B0[2][2], B1[2][2];
    const char* cA = (const char*)g.A + (size_t)cur.pm * tstep; const char* cB = (const char*)g.Bt + (size_t)cur.pn * tstep;
    S.a_ready(cur);
    if constexpr (SP2) {
        PG8_STAGE(PG8_SB(0, 0), cB, voffB); PG8_STAGE(PG8_SB(0, 1), cB + hstep, voffB); PG8_STAGE(PG8_SA(0, 0), cA, voffA); PG8_STAGE(PG8_SA(0, 1), cA + hstep, voffA);
        if (wr == 1) PG8_BAR;
        PG8_WAIT_V(2); PG8_BAR;
        PG8_STAGE(PG8_SB(1, 0), cB + kstep, voffB); PG8_STAGE(PG8_SA(1, 0), cA + kstep, voffA); PG8_STAGE(PG8_SB(1, 1), cB + hstep + kstep, voffB);
        PG8_WAIT_V(6); PG8_BAR;
    } else {
        PG8_STAGE(PG8_SB(0, 0), cB, voffB); PG8_STAGE(PG8_SA(0, 0), cA, voffA); PG8_STAGE(PG8_SB(0, 1), cB + hstep, voffB); PG8_STAGE(PG8_SA(0, 1), cA + hstep, voffA);
        if (wr == 1) PG8_BAR;
        PG8_WAIT_V(4); PG8_BAR;
        PG8_STAGE(PG8_SB(1, 0), cB + kstep, voffB); PG8_STAGE(PG8_SA(1, 0), cA + kstep, voffA); PG8_STAGE(PG8_SB(1, 1), cB + hstep + kstep, voffB);
        PG8_WAIT_V(6); PG8_BAR;
    }
    for (;;) {
        const bool has_next = S.next(ui + 1, nxt);
        const char* nA = has_next ? (const char*)g.A + (size_t)nxt.pm * tstep : cA; const char* nB = has_next ? (const char*)g.Bt + (size_t)nxt.pn * tstep : cB;
        for (int t = 0; t < nt; t += 2) {
            const bool last = (t == nt - 2);
            const char* a1 = cA + (size_t)(t + 1) * kstep;
            const char* a2 = last ? nA : cA + (size_t)(t + 2) * kstep; const char* b2 = last ? nB : cB + (size_t)(t + 2) * kstep;
            const char* a3 = a2 + kstep; const char* b3 = b2 + kstep;
            if (last && has_next) S.a_ready(nxt);
            if constexpr (Epi::HAS_PRE) { if (last) E.pre(cur, wc, fq, pre); }
            if constexpr (SP2) {
            PG8_LDB(B0, 0, 0); PG8_LDB(B1, 0, 1); PG8_SCHED; PG8_LDA(At, 0, 0); PG8_STAGE(PG8_SA(1, 1), a1 + hstep, voffA);
            PG8_WAIT_V(8); PG8_WAIT_L(0); PG8_BAR; PG8_MMA(0, 0, At, B0); PG8_MMA(0, 1, At, B1); PG8_BAR; PG8_SCHED;
            PG8_LDA(At, 0, 1); PG8_STAGE(PG8_SB(0, 0), b2, voffB); PG8_STAGE(PG8_SB(0, 1), b2 + hstep, voffB); PG8_STAGE(PG8_SA(0, 0), a2, voffA);
            PG8_WAIT_V(8); PG8_WAIT_L(0); PG8_BAR; PG8_MMA(1, 0, At, B0); PG8_MMA(1, 1, At, B1); PG8_BAR; PG8_SCHED;
            PG8_LDB(B0, 1, 0); PG8_LDB(B1, 1, 1); PG8_SCHED; PG8_LDA(At, 1, 0); PG8_STAGE(PG8_SA(0, 1), a2 + hstep, voffA);
            PG8_WAIT_V(8); PG8_WAIT_L(0); PG8_BAR; PG8_MMA(0, 0, At, B0); PG8_MMA(0, 1, At, B1); PG8_BAR; PG8_SCHED;
            PG8_LDA(At, 1, 1); PG8_STAGE(PG8_SB(1, 0), b3, voffB); PG8_STAGE(PG8_SB(1, 1), b3 + hstep, voffB); PG8_STAGE(PG8_SA(1, 0), a3, voffA);
            PG8_WAIT_V(8); PG8_WAIT_L(0); PG8_BAR; PG8_MMA(1, 0, At, B0); PG8_MMA(1, 1, At, B1); PG8_BAR; PG8_SCHED;
            } else {
            PG8_LDB(B0, 0, 0); PG8_SCHED; PG8_LDA(At, 0, 0); PG8_STAGE(PG8_SA(1, 1), a1 + hstep, voffA);
            PG8_WAIT_L(8); PG8_BAR; PG8_WAIT_L(0); PG8_MMA(0, 0, At, B0); PG8_BAR; PG8_SCHED;
            PG8_LDB(B1, 0, 1); PG8_STAGE(PG8_SB(0, 0), b2, voffB);
            PG8_BAR; PG8_WAIT_L(0); PG8_MMA(0, 1, At, B1); PG8_BAR;
            PG8_LDA(At, 0, 1); PG8_STAGE(PG8_SA(0, 0), a2, voffA);
            PG8_BAR; PG8_WAIT_L(0); PG8_MMA(1, 0, At, B0); PG8_BAR; PG8_SCHED;
            PG8_STAGE(PG8_SB(0, 1), b2 + hstep, voffB);
            PG8_WAIT_V(6); PG8_BAR; PG8_MMA(1, 1, At, B1); PG8_BAR;
            PG8_LDB(B0, 1, 0); PG8_SCHED; PG8_LDA(At, 1, 0); PG8_STAGE(PG8_SA(0, 1), a2 + hstep, voffA);
            PG8_WAIT_L(8); PG8_BAR; PG8_WAIT_L(0); PG8_MMA(0, 0, At, B0); PG8_BAR; PG8_SCHED;
            PG8_LDB(B1, 1, 1); PG8_STAGE(PG8_SB(1, 0), b3, voffB);
            PG8_BAR; PG8_WAIT_L(0); PG8_MMA(0, 1, At, B1); PG8_BAR;
            PG8_LDA(At, 1, 1); PG8_STAGE(PG8_SA(1, 0), a3, voffA);
            PG8_BAR; PG8_WAIT_L(0); PG8_MMA(1, 0, At, B0); PG8_BAR; PG8_SCHED;
            PG8_STAGE(PG8_SB(1, 1), b3 + hstep, voffB);
            PG8_WAIT_V(6); PG8_BAR; PG8_MMA(1, 1, At, B1); PG8_BAR;
            }
        }
        if constexpr (ALIGN_EPI) { if (wr == 0) PG8_BAR; }
        if constexpr (!Epi::AFTER_DRAIN) { if constexpr (Epi::HAS_PRE) E(acc, cur, wr, wc, fr, fq, pre); else E(acc, cur, wr, wc, fr, fq); S.done(cur); }
        if (!has_next) break;
#pragma unroll
        for (int a = 0; a < 2; ++a)
#pragma unroll
            for (int b = 0; b < 2; ++b)
#pragma unroll
                for (int m = 0; m < 4; ++m)
#pragma unroll
                    for (int n = 0; n < 2; ++n) acc[a][b][m][n] = (f32x4){0.f, 0.f, 0.f, 0.f};
        cur = nxt; cA = nA; cB = nB; ++ui;
        if constexpr (ALIGN_EPI) { if (wr == 1) PG8_BAR; }
    }
    PG8_WAIT_V(0);
    if constexpr (!ALIGN_EPI) { if (wr == 0) PG8_BAR; }
    PG8_BAR;
    if constexpr (Epi::AFTER_DRAIN) { E.fused(acc, cur, wr, wc, fr, fq, lds, wid, lane); S.done(cur); }
#undef PG8_SA
#undef PG8_SB
#undef PG8_STAGE
#undef PG8_LDA
#undef PG8_LDB
#undef PG8_MMA
#undef PG8_CAT8
#undef PG8_WAIT_V
#undef PG8_WAIT_L
#undef PG8_BAR
#undef PG8_SCHED
}
}
#ifndef PG8_SP2
#define PG8_SP2 true
#endif
#ifndef PG8_ALIGN
#define PG8_ALIGN true
#endif
#ifndef MK_PER_PHASE
#define MK_PER_PHASE 0
#endif
constexpr int NWAVES = 8;
constexpr int BATCH = 4, T = 4096, D = 2048, M = BATCH * T, FF = 8192, NPROJ = 6144, INCOLS = 6160;
constexpr int O_CB = 0, O_CC = 1024, O_CX = 2048, O_Q = 3072, O_K = 3584, O_V = 4096, O_R = 5120, O_GL = 6144;
constexpr float EPS = 1e-6f;
constexpr int NPHASE = 16;

constexpr size_t MiB = 1u << 20;
constexpr size_t WS_CTL = 0, CTL_ZERO_BYTES = 1 * MiB;
constexpr size_t WS_GLOW = 1 * MiB;
constexpr size_t WS_WA = 2 * MiB;
constexpr size_t WS_WB = 34 * MiB;
constexpr size_t WS_WC = 98 * MiB;
constexpr size_t WS_ACT = 162 * MiB;
constexpr size_t WS_Y = 226 * MiB;
constexpr size_t WS_PROJ = 290 * MiB;
constexpr size_t WS_A8 = WS_WB;
constexpr float QKV_WSCALE = 64.0f;
constexpr size_t SSX_OFF = 896 * 1024;
constexpr size_t CMAX0_OFF = 128 * 1024, CMAXQ_OFF = 160 * 1024;
constexpr size_t OUT_W8A = 64 * MiB, OUT_X8A = 80 * MiB, OUT_WQ8 = 0, OUT_WO = 32 * MiB;
constexpr float CLIP_X1 = 4.6f * 1.30f, CLIP_X2 = 4.6f * 1.40f;
constexpr size_t WS_W8 = WS_WB;
constexpr size_t WS_X8 = WS_WB + 32 * MiB;
constexpr size_t CMAX1_OFF = 96 * 1024;
constexpr size_t WS_H = WS_Y;
constexpr size_t WS_END = 482 * MiB;
static_assert(WS_H + (size_t)M * FF * 2 == WS_END && WS_PROJ + (size_t)M * NPROJ * 2 == WS_END, "ws map");
constexpr int CW_BAR = 4096;
constexpr size_t SS_OFF = 256 * 1024;
static_assert(SS_OFF + 4 * (size_t)M * 8 <= 768 * 1024, "ss inside the memset region, below DV");
constexpr size_t FCNT_OFF = 64 * 1024;

constexpr int RING_OFF = 0, RING_BYTES = 131072;
constexpr int LDSCTL_OFF = 140288, MISC_OFF = LDSCTL_OFF + 320;
constexpr int RFT_OFF = RING_OFF + RING_BYTES + 1024;
constexpr int LDS_BYTES = 147456;
static_assert(MISC_OFF + 128 <= LDS_BYTES, "LDS map");

#define GAS __attribute__((address_space(1)))
#define LAS __attribute__((address_space(3)))
typedef unsigned short bf16;
typedef unsigned v4u __attribute__((ext_vector_type(4)));
typedef float f32x4 __attribute__((ext_vector_type(4)));
typedef short bf16x8 __attribute__((ext_vector_type(8)));
typedef GAS unsigned gu32;
typedef GAS unsigned long long gu64;
#define RLX_AGENT __ATOMIC_RELAXED, __HIP_MEMORY_SCOPE_AGENT
#define LDS_WAIT() asm volatile("s_waitcnt lgkmcnt(0)" ::: "memory")
#define VM_WAIT() asm volatile("s_waitcnt vmcnt(0)" ::: "memory")
__device__ __forceinline__ unsigned long long rt() { return __builtin_amdgcn_s_memrealtime(); }
__device__ __forceinline__ unsigned f2bf(float f) { unsigned u = __builtin_bit_cast(unsigned, f); return (u + 0x7fffu + ((u >> 16) & 1u)) >> 16; }
__device__ __forceinline__ unsigned pk2(float lo, float hi) { return f2bf(lo) | (f2bf(hi) << 16); }

#define XB_TMO      128
#define XB_XCNT(j)  (256  + 64 * (j))
#define XB_XSUB(j)  (1280 + 64 * (j))
#define XB_XGEN(j)  (2304 + 64 * (j))
#define XB_TOP      3328
#define XB_TOPGEN   3392
#define XCD_BAR_WORDS 3456
#define XB_SPIN_CAP (1u << 18)

__device__ __forceinline__ unsigned xb_ld(unsigned* p)              { return __hip_atomic_load(p, __ATOMIC_RELAXED, __HIP_MEMORY_SCOPE_AGENT); }
__device__ __forceinline__ unsigned xb_add(unsigned* p, unsigned v) { return __hip_atomic_fetch_add(p, v, __ATOMIC_RELAXED, __HIP_MEMORY_SCOPE_AGENT); }
__device__ __forceinline__ unsigned xb_xcc_id() { return (unsigned)__builtin_amdgcn_s_getreg((3 << 11) | 20) & 0xFu; }
#define XB_SPIN(cond, bar) do { unsigned _sp = 0; while (cond) { __builtin_amdgcn_s_sleep(1); \
    if ((++_sp & 255u) == 0u) { if (xb_ld(&(bar)[XB_TMO])) break; if (_sp > XB_SPIN_CAP) { atomicAdd(&(bar)[XB_TMO], 1u); break; } } } } while (0)

struct XcdBarrier {
    unsigned* bar; unsigned x;
    volatile LAS unsigned* st;
    bool w0;
};

__device__ __forceinline__ XcdBarrier xcd_barrier_post(unsigned* bar, volatile LAS unsigned* st, int wave) {
    XcdBarrier b; b.bar = bar; b.x = xb_xcc_id(); b.st = st; b.w0 = (wave == 0);
    if (b.w0 && pg8::fresh_lane() == 0) (void)xb_add(&bar[XB_XCNT(b.x)], 1u);
    return b;
}
__device__ __forceinline__ void xcd_barrier_complete(unsigned* bar, unsigned x, unsigned& nloc, unsigned& nx) {
    const unsigned G = gridDim.x * gridDim.y * gridDim.z;
    unsigned sum, cnt, mine, sp = 0u;
    for (;;) {
        sum = 0u; cnt = 0u; mine = 0u;
#pragma unroll
        for (unsigned j = 0; j < 16; ++j) { const unsigned c = xb_ld(&bar[XB_XCNT(j)]); sum += c; cnt += (c > 0u) ? 1u : 0u; mine = (j == x) ? c : mine; }
        if (sum == G) break;
        __builtin_amdgcn_s_sleep(1);
        if ((++sp & 255u) == 0u) { if (xb_ld(&bar[XB_TMO])) break; if (sp > XB_SPIN_CAP) { atomicAdd(&bar[XB_TMO], 1u); break; } }
    }
    nloc = mine > 0u ? mine : 1u; nx = cnt > 0u ? cnt : 1u;
}

__device__ __forceinline__ void xcd_barrier(const XcdBarrier& b) {
    asm volatile("s_waitcnt vmcnt(0)" ::: "memory");
    __syncthreads();
    if (b.w0 && pg8::fresh_lane() == 0) {
        unsigned* bar = b.bar;
        __builtin_amdgcn_s_waitcnt(0);
        unsigned nloc = b.st[0], nx = b.st[1];
        if (nloc == 0u) { xcd_barrier_complete(bar, b.x, nloc, nx); b.st[0] = nloc; b.st[1] = nx; }
        const unsigned old = xb_add(&bar[XB_XSUB(b.x)], 1u);
        const unsigned gen = old / nloc;
        if (old + 1u == (gen + 1u) * nloc) {
            __builtin_amdgcn_fence(__ATOMIC_RELEASE, "agent");
            asm volatile("s_waitcnt vmcnt(0)" ::: "memory");
            const unsigned og = xb_add(&bar[XB_TOP], 1u);
            const unsigned tg = og / nx;
            if (og + 1u == (tg + 1u) * nx) xb_add(&bar[XB_TOPGEN], 1u);
            else XB_SPIN(xb_ld(&bar[XB_TOPGEN]) == tg, bar);
            __builtin_amdgcn_fence(__ATOMIC_ACQUIRE, "agent");
            xb_add(&bar[XB_XGEN(b.x)], 1u);
            asm volatile("s_waitcnt vmcnt(0)" ::: "memory");
        } else {
            XB_SPIN(xb_ld(&bar[XB_XGEN(b.x)]) == gen, bar);
            __builtin_amdgcn_fence(__ATOMIC_ACQUIRE, "agent");
            asm volatile("s_waitcnt vmcnt(0)" ::: "memory");
        }
    }
    __syncthreads();
}

struct Frame {
    LAS unsigned char* lds;
    volatile LAS unsigned* MISC;
    gu32* ctl;
    int tid, lane, wave;
    int vcu, G;
    const float* in[14];
    float* out; unsigned char* ws;
};
__device__ __forceinline__ float bf2f(unsigned short b) { return __uint_as_float(((unsigned)b) << 16); }
__device__ __forceinline__ float bflo(unsigned w) { return __uint_as_float(w << 16); }
__device__ __forceinline__ float bfhi(unsigned w) { return __uint_as_float(w & 0xffff0000u); }
__device__ __forceinline__ float wave_sum(float v) {
#pragma unroll
    for (int o = 1; o < 64; o <<= 1) v += __shfl_xor(v, o);
    return v;
}
__device__ __forceinline__ float wave_max(float v) {
#pragma unroll
    for (int o = 1; o < 64; o <<= 1) v = fmaxf(v, __shfl_xor(v, o));
    return v;
}
typedef short s16x4 __attribute__((ext_vector_type(4)));
#define TR16(p) __builtin_amdgcn_ds_read_tr16_b64_v4i16((LAS s16x4*)(p))
#define MFMA16(a, b, c) __builtin_amdgcn_mfma_f32_16x16x32_bf16((a), (b), (c), 0, 0, 0)
__device__ __forceinline__ bf16x8 cat8(s16x4 a, s16x4 b) { return (bf16x8){a[0], a[1], a[2], a[3], b[0], b[1], b[2], b[3]}; }
__device__ __forceinline__ float logsig16(float x) { return (fminf(x, 0.f) - 0.6931471805599453f * __builtin_amdgcn_logf(1.0f + __builtin_amdgcn_exp2f(-1.4426950408889634f * fabsf(x)))) * (1.0f / 16.0f); }
__device__ __forceinline__ void p0_tr_load(f32x4 (&t)[16], const float* W, int N, int ldw, int item, int lane, const float* gk, unsigned* cmax = nullptr) {
    const int nblk = N / 64, kb = item / nblk, nb = item % nblk, k0 = 64 * kb, n0 = 64 * nb, ks = lane >> 4, n4 = (lane & 15) * 4;
#pragma unroll
    for (int i = 0; i < 16; ++i) t[i] = *(const GAS f32x4*)(W + (size_t)(k0 + 4 * i + ks) * ldw + n0 + n4);
    if (gk) {
#pragma unroll
        for (int i = 0; i < 16; ++i) t[i] = t[i] * gk[k0 + 4 * i + ks]; }
    if (cmax) {
        f32x4 mx = (f32x4){0.f, 0.f, 0.f, 0.f};
#pragma unroll
        for (int i = 0; i < 16; ++i) { mx.x = fmaxf(mx.x, fabsf(t[i].x)); mx.y = fmaxf(mx.y, fabsf(t[i].y)); mx.z = fmaxf(mx.z, fabsf(t[i].z)); mx.w = fmaxf(mx.w, fabsf(t[i].w)); }
#pragma unroll
        for (int o = 16; o < 64; o <<= 1) { mx.x = fmaxf(mx.x, __shfl_xor(mx.x, o)); mx.y = fmaxf(mx.y, __shfl_xor(mx.y, o)); mx.z = fmaxf(mx.z, __shfl_xor(mx.z, o)); mx.w = fmaxf(mx.w, __shfl_xor(mx.w, o)); }
        if (ks == 0) { unsigned* c = cmax + n0 + n4; atomicMax(c, __float_as_uint(mx.x)); atomicMax(c + 1, __float_as_uint(mx.y)); atomicMax(c + 2, __float_as_uint(mx.z)); atomicMax(c + 3, __float_as_uint(mx.w)); } }
}
__device__ __forceinline__ int convmap(int n) { return (n >= 1024 && n < 3072) ? (1024 + (((n - 1024) & 1023) >> 7) * 256 + (n >= 2048 ? 128 : 0) + (n & 127)) : n; }
template <bool REMAP> __device__ __forceinline__ void p0_tr_store(const f32x4 (&t)[16], int K, int N, bf16* WT, LAS float* scr, int item, int lane) {
    const int nblk = N / 64, kb = item / nblk, nb = item % nblk, k0 = 64 * kb, ks = lane >> 4, n4 = (lane & 15) * 4; const int n0 = REMAP ? convmap(64 * nb) : 64 * nb;
#pragma unroll
    for (int i = 0; i < 16; ++i) { LAS float* d = scr + (4 * i + ks) * 65 + n4; d[0] = t[i].x; d[1] = t[i].y; d[2] = t[i].z; d[3] = t[i].w; }
    LDS_WAIT(); asm volatile("" ::: "memory");
    const int c = lane & 7;
#pragma unroll
    for (int j = 0; j < 8; ++j) { const int n = (lane >> 3) + 8 * j; const LAS float* s = scr + (8 * c) * 65 + n;
        v4u o; o.x = pk2(s[0 * 65], s[1 * 65]); o.y = pk2(s[2 * 65], s[3 * 65]); o.z = pk2(s[4 * 65], s[5 * 65]); o.w = pk2(s[6 * 65], s[7 * 65]);
        *(GAS v4u*)(WT + (size_t)(n0 + n) * K + k0 + 8 * c) = o; }
    LDS_WAIT(); asm volatile("" ::: "memory");
}
__device__ __forceinline__ void p0_tr_store8(const f32x4 (&t)[16], int K, int N, unsigned char* WT, LAS float* scr, int item, int lane, float sc) {
    const int nblk = N / 64, kb = item / nblk, nb = item % nblk, k0 = 64 * kb, ks = lane >> 4, n4 = (lane & 15) * 4; const int n0 = 64 * nb;
#pragma unroll
    for (int i = 0; i < 16; ++i) { LAS float* d = scr + (4 * i + ks) * 65 + n4; d[0] = t[i].x; d[1] = t[i].y; d[2] = t[i].z; d[3] = t[i].w; }
    LDS_WAIT(); asm volatile("" ::: "memory");
    const int c = lane & 7;
#pragma unroll
    for (int j = 0; j < 8; ++j) { const int n = (lane >> 3) + 8 * j; const LAS float* s = scr + (8 * c) * 65 + n;
        pg8::u32x2 o; o.x = pg8::pk4_fp8(s[0 * 65] * sc, s[1 * 65] * sc, s[2 * 65] * sc, s[3 * 65] * sc); o.y = pg8::pk4_fp8(s[4 * 65] * sc, s[5 * 65] * sc, s[6 * 65] * sc, s[7 * 65] * sc);
        *(GAS pg8::u32x2*)(WT + (size_t)(n0 + n) * K + k0 + 8 * c) = o; }
    LDS_WAIT(); asm volatile("" ::: "memory");
}
__device__ __forceinline__ void transpose_all8(Frame& F, const float* W, int K, int N, int ldw, unsigned char* WT, const float* gk, float sc) {
    LAS float* scr = (LAS float*)(F.lds + RING_OFF + F.wave * 16640);
    const int gw = F.vcu * NWAVES + F.wave, NGW = F.G * NWAVES, nitems = (K / 64) * (N / 64);
    int it = gw; if (it >= nitems) return;
    f32x4 t[16], t2[16];
    p0_tr_load(t, W, N, ldw, it, F.lane, gk);
    for (;;) { const int nx = it + NGW; const bool more = nx < nitems;
        if (more) p0_tr_load(t2, W, N, ldw, nx, F.lane, gk);
        p0_tr_store8(t, K, N, WT, scr, it, F.lane, sc);
        if (!more) break;
#pragma unroll
        for (int i = 0; i < 16; ++i) t[i] = t2[i];
        it = nx; }
}
template <bool REMAP = false> __device__ __forceinline__ void transpose_all(Frame& F, const float* W, int K, int N, int ldw, bf16* WT, const float* gk = nullptr, unsigned* cmax = nullptr) {
    LAS float* scr = (LAS float*)(F.lds + RING_OFF + F.wave * 16640);
    const int gw = F.vcu * NWAVES + F.wave, NGW = F.G * NWAVES, nitems = (K / 64) * (N / 64);
    int it = gw; if (it >= nitems) return;
    f32x4 t[16], t2[16];
    p0_tr_load(t, W, N, ldw, it, F.lane, gk, cmax);
    for (;;) { const int nx = it + NGW; const bool more = nx < nitems;
        if (more) p0_tr_load(t2, W, N, ldw, nx, F.lane, gk, cmax);
        p0_tr_store<REMAP>(t, K, N, WT, scr, it, F.lane);
        if (!more) break;
#pragma unroll
        for (int i = 0; i < 16; ++i) t[i] = t2[i];
        it = nx; }
}

__device__ __forceinline__ void quant_rows_i8(Frame& F, const bf16* WT, unsigned char* W8, const unsigned* cmax, int N, int K) {
    const int gw = F.vcu * NWAVES + F.wave, NGW = F.G * NWAVES;
    for (int n = gw; n < N; n += NGW) { const float sc = 127.0f / fmaxf(__uint_as_float(cmax[n]), 1e-30f);
        const bf16* src = WT + (size_t)n * K + 8 * F.lane; unsigned char* dst = W8 + (size_t)n * K + 8 * F.lane;
        v4u wv[4];
#pragma unroll
        for (int j = 0; j < 4; ++j) wv[j] = *(const GAS v4u*)(src + 512 * j);
#pragma unroll
        for (int j = 0; j < 4; ++j) { const v4u w = wv[j]; pg8::u32x2 o;
            o.x = pg8::pk4_i8(bflo(w.x) * sc, bfhi(w.x) * sc, bflo(w.y) * sc, bfhi(w.y) * sc); o.y = pg8::pk4_i8(bflo(w.z) * sc, bfhi(w.z) * sc, bflo(w.w) * sc, bfhi(w.w) * sc);
            *(GAS pg8::u32x2*)(dst + 512 * j) = o; } }
}
__device__ __forceinline__ void conv_set_a(Frame& F) {
    const float* w1 = F.in[12]; const float* w2 = F.in[13];
    transpose_all(F, w2, FF, D, D, (bf16*)(F.ws + WS_WB + 32 * MiB));
    transpose_all(F, w1 + (size_t)D * FF, D, FF, FF, (bf16*)(F.ws + WS_WC), F.in[2] + D, (unsigned*)(F.ws + WS_CTL + CMAX1_OFF));
    transpose_all(F, w2 + (size_t)D * FF, FF, D, D, (bf16*)(F.ws + WS_WC + 32 * MiB));
}
__device__ __forceinline__ void conv_set_b(Frame& F) {
    transpose_all(F, F.in[9], D, D, D, (bf16*)(F.ws + WS_WA + 24 * MiB));
    transpose_all(F, F.in[12], D, FF, FF, (bf16*)(F.ws + WS_WB), F.in[2], (unsigned*)(F.ws + WS_CTL + CMAX0_OFF));
    transpose_all(F, F.in[10], D, NPROJ, NPROJ, (bf16*)(F.ws + WS_WA), F.in[1] + D, (unsigned*)(F.ws + WS_CTL + CMAXQ_OFF));
    transpose_all(F, F.in[11], D, D, D, (bf16*)((unsigned char*)F.out + OUT_WO));
}
__device__ __forceinline__ void p0_prologue(Frame& F) {
    const float* w_in = F.in[4];
    transpose_all<true>(F, w_in, D, NPROJ, INCOLS, (bf16*)(F.ws + WS_WA));
    const int gw = F.vcu * NWAVES + F.wave, NGW = F.G * NWAVES;
    const float* x = F.in[0]; const float* g = F.in[1];
    bf16* XN = (bf16*)(F.ws + WS_ACT);
    f32x4 gg8[8];
#pragma unroll
    for (int j = 0; j < 8; ++j) gg8[j] = *((const GAS f32x4*)g + F.lane + 64 * j);
    for (int m = gw; m < M; m += NGW) {
        const GAS f32x4* xr = (const GAS f32x4*)(x + (size_t)m * D) + F.lane;
        f32x4 v[8]; float s = 0.f;
#pragma unroll
        for (int j = 0; j < 8; ++j) { v[j] = xr[64 * j]; s += (v[j].x * v[j].x + v[j].y * v[j].y) + (v[j].z * v[j].z + v[j].w * v[j].w); }
        const float ssum = wave_sum(s); const float rstd = 1.0f / sqrtf(ssum * (1.f / D) + EPS);
        if (F.lane == 0) ((unsigned long long*)(F.ws + WS_CTL + SSX_OFF))[m] = (unsigned long long)(ssum * 1048576.0f + 0.5f);
        GAS unsigned long long* o8 = (GAS unsigned long long*)(XN + (size_t)m * D) + F.lane;
#pragma unroll
        for (int j = 0; j < 8; ++j) { const f32x4 gg = gg8[j]; v[j] = v[j] * gg * rstd;
            o8[64 * j] = (unsigned long long)pk2(v[j].x, v[j].y) | ((unsigned long long)pk2(v[j].z, v[j].w) << 32); }
    }
}
__device__ __forceinline__ void glow_mfma(Frame& F) {
    constexpr int WS_ = 2056;
    LAS bf16* WgT = (LAS bf16*)F.lds; const float* w_in = F.in[4]; const bf16* XN = (const bf16*)(F.ws + WS_ACT); float* GL = (float*)(F.ws + WS_GLOW);
    for (int k = F.tid; k < D; k += NWAVES * 64) { const f32x4* p = (const f32x4*)(w_in + (size_t)k * INCOLS + O_GL); const f32x4 a = p[0], b = p[1], c = p[2], d = p[3];
        const float vv[16] = {a.x, a.y, a.z, a.w, b.x, b.y, b.z, b.w, c.x, c.y, c.z, c.w, d.x, d.y, d.z, d.w};
#pragma unroll
        for (int cc = 0; cc < 16; ++cc) WgT[cc * WS_ + k] = (bf16)f2bf(vv[cc]); }
    __syncthreads();
    const int g = F.lane >> 4, li = F.lane & 15;
    for (int task = F.wave * F.G + (int)blockIdx.x; task < M / 16; task += F.G * NWAVES) { const size_t m0 = (size_t)task * 16;
        f32x4 acc = (f32x4){0.f, 0.f, 0.f, 0.f}; const bf16* ap = XN + (m0 + li) * D + 8 * g; const LAS bf16* bp = WgT + li * WS_ + 8 * g;
#pragma unroll 16
        for (int ks = 0; ks < 64; ++ks) acc = MFMA16(*(const bf16x8*)(ap + 32 * ks), *(const LAS bf16x8*)(bp + 32 * ks), acc);
#pragma unroll
        for (int r = 0; r < 4; ++r) GL[(m0 + 4 * g + r) * 16 + li] = acc[r]; }
    __syncthreads();
}
__device__ __forceinline__ void unpack8(const v4u w, float (&f)[8]) { f[0] = bflo(w.x); f[1] = bfhi(w.x); f[2] = bflo(w.y); f[3] = bfhi(w.y); f[4] = bflo(w.z); f[5] = bfhi(w.z); f[6] = bflo(w.w); f[7] = bfhi(w.w); }
__device__ __forceinline__ void conv_mix(Frame& F) {
    const bf16* PROJ = (const bf16*)(F.ws + WS_PROJ); bf16* Y = (bf16*)(F.ws + WS_Y); const float* cw = F.in[5];
    for (int idx = blockIdx.x * NWAVES * 64 + F.tid; idx < (M / 16) * 128; idx += F.G * NWAVES * 64) { const int cg = idx & 127, c = cg * 8; const size_t m0 = (size_t)(idx >> 7) * 16; const int t0 = (int)(m0 & (T - 1));
        float w0[8], w1[8], w2[8];
#pragma unroll
        for (int e2 = 0; e2 < 8; ++e2) { w0[e2] = cw[c + e2]; w1[e2] = cw[1024 + c + e2]; w2[e2] = cw[2048 + c + e2]; }
        float u1[8], u2[8];
#pragma unroll
        for (int e2 = 0; e2 < 8; ++e2) { u1[e2] = 0.f; u2[e2] = 0.f; }
        if (t0 > 0) { unpack8(*(const v4u*)(PROJ + (m0 - 1) * NPROJ + O_CC + c), u1); unpack8(*(const v4u*)(PROJ + (m0 - 2) * NPROJ + O_CC + c), u2); }
        for (int i4 = 0; i4 < 16; i4 += 4) { v4u rab[4], ru[4];
#pragma unroll
            for (int j = 0; j < 4; ++j) { const bf16* row = PROJ + (m0 + i4 + j) * NPROJ; rab[j] = *(const v4u*)(row + O_CB + c); ru[j] = *(const v4u*)(row + O_CC + c); }
            asm volatile("" ::: "memory");
#pragma unroll
            for (int j = 0; j < 4; ++j) { float ab[8], u0[8], y[8]; unpack8(rab[j], ab); unpack8(ru[j], u0);
#pragma unroll
                for (int e2 = 0; e2 < 8; ++e2) { y[e2] = ab[e2] * (w0[e2] * u2[e2] + w1[e2] * u1[e2] + w2[e2] * u0[e2]); u2[e2] = u1[e2]; u1[e2] = u0[e2]; }
                v4u o; o.x = pk2(y[0], y[1]); o.y = pk2(y[2], y[3]); o.z = pk2(y[4], y[5]); o.w = pk2(y[6], y[7]);
                *(v4u*)(Y + (m0 + i4 + j) * D + c) = o; }
            asm volatile("" ::: "memory"); } }
}
typedef _Float16 h16; typedef _Float16 h16x8 __attribute__((ext_vector_type(8)));
__device__ __forceinline__ void unpack_h8(const v4u w, float* f) { const h16x8 h = __builtin_bit_cast(h16x8, w);
#pragma unroll
    for (int i = 0; i < 8; ++i) f[i] = (float)h[i]; }
constexpr int KS = 136, VS = 264;
constexpr size_t WS_GB = WS_ACT, WS_SLOC = WS_ACT + 32 * MiB, DV_OFF = 768 * 1024;
__device__ __forceinline__ void stage_v64(const bf16* src  , LAS bf16* Vs, int tid) {
#pragma unroll
    for (int r = 0; r < 4; ++r) { const int idx = tid + 512 * r, row = idx >> 5, pc = idx & 31;
        const v4u val = *(const v4u*)(src + (size_t)row * NPROJ + pc * 8); *(LAS v4u*)(Vs + row * VS + pc * 8) = val; }
}
__device__ __forceinline__ void gla_g1(Frame& F) {
    const bf16* PROJ = (const bf16*)(F.ws + WS_PROJ); const float* GL = (const float*)(F.ws + WS_GLOW);
    h16* GB = (h16*)(F.ws + WS_GB); float* SLOC = (float*)(F.ws + WS_SLOC); float* DV = (float*)(F.ws + WS_CTL + DV_OFF);
    const float* wg2 = F.in[6]; const float* bg = F.in[7];
    LAS float* qtot = (LAS float*)(F.lds); LAS bf16* Kh = (LAS bf16*)(F.lds + 2048); LAS bf16* Vs = (LAS bf16*)(F.lds + 2048 + 64 * KS * 2);
    LAS float* GLs = (LAS float*)(F.lds + 2048 + 64 * KS * 2 + 64 * VS * 2);
    const int w = F.wave;
    for (int u = blockIdx.x; u < 256; u += F.G) { const int bh = u >> 4, s = u & 15, b = bh >> 2, h = bh & 3; const size_t m0 = (size_t)b * T + s * 256;
        int tid = F.tid; asm volatile("" : "+v"(tid));
        const int ch = tid & 127, q = tid >> 7, g = (tid >> 4) & 3, li = tid & 15, tq = li >> 2, tp = li & 3;
        unsigned short kraw[16]; v4u vraw[4];
#define G1_LOAD(c_) do { const size_t mb_ = m0 + (c_) * 64 + q * 16; _Pragma("unroll") for (int i = 0; i < 16; ++i) kraw[i] = PROJ[(mb_ + i) * NPROJ + O_K + h * 128 + ch]; \
            _Pragma("unroll") for (int r = 0; r < 4; ++r) { const int idx = tid + 512 * r, row = idx >> 5, pc = idx & 31; vraw[r] = *(const v4u*)(PROJ + (m0 + (c_) * 64 + row) * NPROJ + O_V + h * 256 + pc * 8); } } while (0)
        { const f32x4* gp = (const f32x4*)(GL + m0 * 16) + tid; const f32x4 g0 = gp[0], g1 = gp[512]; G1_LOAD(3);
          *((LAS f32x4*)GLs + tid) = g0; *((LAS f32x4*)GLs + 512 + tid) = g1; }
        float wg[16];
#pragma unroll
        for (int j = 0; j < 16; ++j) wg[j] = wg2[j * 512 + h * 128 + ch];
        const float bias = bg[h * 128 + ch];
        f32x4 acc[8][2];
#pragma unroll
        for (int rt = 0; rt < 8; ++rt) { acc[rt][0] = (f32x4){0.f, 0.f, 0.f, 0.f}; acc[rt][1] = (f32x4){0.f, 0.f, 0.f, 0.f}; }
        float suffix = 0.f;
        __syncthreads();
        for (int c = 3; c >= 0; --c) {
            float loc[16]; float run = 0.f; const size_t mb = m0 + c * 64 + q * 16;
#pragma unroll
            for (int i = 0; i < 16; ++i) { const LAS f32x4* gl = (const LAS f32x4*)(GLs + (c * 64 + q * 16 + i) * 16); const f32x4 a0 = gl[0], a1 = gl[1], a2 = gl[2], a3 = gl[3];
                const float xx = bias + ((a0.x * wg[0] + a0.y * wg[1]) + (a0.z * wg[2] + a0.w * wg[3])) + ((a1.x * wg[4] + a1.y * wg[5]) + (a1.z * wg[6] + a1.w * wg[7]))
                                      + ((a2.x * wg[8] + a2.y * wg[9]) + (a2.z * wg[10] + a2.w * wg[11])) + ((a3.x * wg[12] + a3.y * wg[13]) + (a3.z * wg[14] + a3.w * wg[15]));
                run += logsig16(xx); loc[i] = run; }
            qtot[q * 128 + ch] = run; __syncthreads();
            float pre = 0.f, ctot = 0.f;
#pragma unroll
            for (int qq = 0; qq < 4; ++qq) { const float v = qtot[qq * 128 + ch]; ctot += v; if (qq < q) pre += v; }
#pragma unroll
            for (int i = 0; i < 16; ++i) { const float gi = pre + loc[i]; GB[(mb + i) * 512 + h * 128 + ch] = (h16)gi;
                Kh[(q * 16 + i) * KS + ch] = (bf16)f2bf(bf2f(kraw[i]) * __builtin_amdgcn_exp2f(1.4426950408889634f * ((ctot - gi) + suffix))); }
#pragma unroll
            for (int r = 0; r < 4; ++r) { const int idx = tid + 512 * r, row = idx >> 5, pc = idx & 31; *(LAS v4u*)(Vs + row * VS + pc * 8) = vraw[r]; }
            __syncthreads();
            if (c > 0) G1_LOAD(c - 1);
#pragma unroll
            for (int ks = 0; ks < 2; ++ks) { const int j0 = 32 * ks + 8 * g + tq; bf16x8 bfr[2];
#pragma unroll
                for (int ct = 0; ct < 2; ++ct) { const LAS bf16* p = Vs + j0 * VS + 32 * w + 16 * ct + 4 * tp; bfr[ct] = cat8(TR16(p), TR16(p + 4 * VS)); }
#pragma unroll
                for (int rt = 0; rt < 8; ++rt) { const LAS bf16* p = Kh + j0 * KS + 16 * rt + 4 * tp; const bf16x8 af = cat8(TR16(p), TR16(p + 4 * KS));
                    acc[rt][0] = MFMA16(af, bfr[0], acc[rt][0]); acc[rt][1] = MFMA16(af, bfr[1], acc[rt][1]); } }
            suffix += ctot;
            __syncthreads();
        }
#undef G1_LOAD
        if (q == 0) DV[(bh * 16 + s) * 128 + ch] = __builtin_amdgcn_exp2f(1.4426950408889634f * suffix);
        float* so = SLOC + (size_t)(bh * 16 + s) * 128 * 256;
#pragma unroll
        for (int rt = 0; rt < 8; ++rt)
#pragma unroll
            for (int ct = 0; ct < 2; ++ct)
#pragma unroll
                for (int r = 0; r < 4; ++r) so[(size_t)(16 * rt + 4 * g + r) * 256 + 32 * w + 16 * ct + li] = acc[rt][ct][r];
    }
}
__device__ __forceinline__ void gla_g2(Frame& F) {
    const float* SLOC = (const float*)(F.ws + WS_SLOC); const float* DV = (const float*)(F.ws + WS_CTL + DV_OFF); bf16* SST = (bf16*)F.out;
    for (int idx = blockIdx.x * NWAVES * 64 + F.tid; idx < 16 * 128 * 64; idx += F.G * NWAVES * 64) { const int vq = idx & 63, ch = (idx >> 6) & 127, bh = idx >> 13;
        f32x4 st = (f32x4){0.f, 0.f, 0.f, 0.f};
        for (int s8 = 0; s8 < 16; s8 += 8) { f32x4 loc[8]; float dd[8];
#pragma unroll
            for (int j = 0; j < 8; ++j) { loc[j] = *(const f32x4*)(SLOC + ((size_t)(bh * 16 + s8 + j) * 128 + ch) * 256 + vq * 4); dd[j] = DV[(bh * 16 + s8 + j) * 128 + ch]; }
            asm volatile("" ::: "memory");
#pragma unroll
            for (int j = 0; j < 8; ++j) { const size_t o = ((size_t)(bh * 16 + s8 + j) * 128 + ch) * 256 + vq * 4;
                *(unsigned long long*)(SST + o) = (unsigned long long)pk2(st.x, st.y) | ((unsigned long long)pk2(st.z, st.w) << 32);
                st = st * dd[j] + loc[j]; }
            asm volatile("" ::: "memory"); } }
}
__device__ __forceinline__ float fexp(float x) { return __builtin_amdgcn_exp2f(x * 1.4426950408889634f); }
struct G3Raw { v4u k0, k1, v[4]; v4u g[2]; };
__device__ __forceinline__ void g3_load_raw(G3Raw& R, const bf16* PROJ, const h16* GB, size_t mrow0  , int h, int srow, int spc, int tid) {
    const size_t m = mrow0 + srow; const v4u* kp = (const v4u*)(PROJ + m * NPROJ + O_K + h * 128 + spc * 16); R.k0 = kp[0]; R.k1 = kp[1];
    const v4u* gp = (const v4u*)(GB + m * 512 + h * 128 + spc * 16); R.g[0] = gp[0]; R.g[1] = gp[1];
#pragma unroll
    for (int r = 0; r < 4; ++r) { const int idx = tid + 512 * r, row = idx >> 5, pc = idx & 31; R.v[r] = *(const v4u*)(PROJ + (mrow0 + row) * NPROJ + O_V + h * 256 + pc * 8); }
}
__device__ __forceinline__ void gla_g3(Frame& F) {
    const bf16* PROJ = (const bf16*)(F.ws + WS_PROJ); const h16* GB = (const h16*)(F.ws + WS_GB); const bf16* SST = (const bf16*)F.out; bf16* Y = (bf16*)(F.ws + WS_Y); const float* gn = F.in[8];
    LAS bf16* QT = (LAS bf16*)(F.lds); LAS bf16* Q2 = (LAS bf16*)(F.lds + 17408); LAS bf16* Sx = (LAS bf16*)(F.lds + 34816);
    LAS bf16* KT = Sx; LAS bf16* Vs = (LAS bf16*)(F.lds + 34816 + 17408); LAS float* RED = (LAS float*)(F.lds + 102400); LAS float* CT = (LAS float*)(F.lds + 102912);
    const int w = F.wave, ti = w & 3, vh = w >> 2;
    const float qscale = 0.08838834764831845f;
    for (int uu = blockIdx.x; uu < 1024; uu += F.G) { const int nl = 3 - (uu >> 8), cu = uu & 255, bh = cu >> 4, s = cu & 15, b = bh >> 2, h = bh & 3;
        const size_t m0 = (size_t)b * T + s * 256, mq = m0 + nl * 64;
        int tid = F.tid; asm volatile("" : "+v"(tid));
        const int g = (tid >> 4) & 3, li = tid & 15, tq = li >> 2, tp = li & 3, srow = tid >> 3, spc = tid & 7;
        const float ctv = (float)GB[(m0 + (tid >> 7) * 64 + 63) * 512 + h * 128 + (tid & 127)];
        const size_t mqr = mq + srow; const v4u* qp = (const v4u*)(PROJ + mqr * NPROJ + O_Q + h * 128 + spc * 16); const v4u qa = qp[0], qb = qp[1];
        const v4u* gqp = (const v4u*)(GB + mqr * 512 + h * 128 + spc * 16); const v4u gq0 = gqp[0], gq1 = gqp[1];
        v4u sraw[8];
        { const bf16* sp = SST + (size_t)(bh * 16 + s) * 128 * 256;
#pragma unroll
            for (int r = 0; r < 8; ++r) { const int idx = tid + 512 * r, row = idx >> 5, pc = idx & 31; sraw[r] = *(const v4u*)(sp + (size_t)row * 256 + pc * 8); } }
        G3Raw R; g3_load_raw(R, PROJ, GB, m0, h, srow, spc, tid);
        CT[tid] = ctv;
        __syncthreads();
        float cpre[16];
#pragma unroll
        for (int e2 = 0; e2 < 16; ++e2) { float a = 0.f; for (int c = 0; c < nl; ++c) a += CT[c * 128 + spc * 16 + e2]; cpre[e2] = a; }
        {
            const unsigned qw[8] = {qa.x, qa.y, qa.z, qa.w, qb.x, qb.y, qb.z, qb.w}; float gg[16]; unpack_h8(gq0, gg); unpack_h8(gq1, gg + 8);
            unsigned o1[8], o2[8];
#pragma unroll
            for (int e2 = 0; e2 < 8; ++e2) { const float x0 = bflo(qw[e2]) * qscale * fexp(gg[2 * e2]), x1 = bfhi(qw[e2]) * qscale * fexp(gg[2 * e2 + 1]);
                o1[e2] = pg8::cvt_pk_bf16(x0, x1); o2[e2] = pg8::cvt_pk_bf16(x0 * fexp(cpre[2 * e2]), x1 * fexp(cpre[2 * e2 + 1])); }
            LAS v4u* d1 = (LAS v4u*)(QT + srow * KS + spc * 16); d1[0] = (v4u){o1[0], o1[1], o1[2], o1[3]}; d1[1] = (v4u){o1[4], o1[5], o1[6], o1[7]};
            LAS v4u* d2 = (LAS v4u*)(Q2 + srow * KS + spc * 16); d2[0] = (v4u){o2[0], o2[1], o2[2], o2[3]}; d2[1] = (v4u){o2[4], o2[5], o2[6], o2[7]};
        }
#pragma unroll
        for (int r = 0; r < 8; ++r) { const int idx = tid + 512 * r, row = idx >> 5, pc = idx & 31; *(LAS v4u*)(Sx + row * VS + pc * 8) = sraw[r]; }
        __syncthreads();
        f32x4 o[8];
#pragma unroll
        for (int vt = 0; vt < 8; ++vt) o[vt] = (f32x4){0.f, 0.f, 0.f, 0.f};
#pragma unroll
        for (int ks = 0; ks < 4; ++ks) { const bf16x8 qf2 = *(const LAS bf16x8*)(Q2 + (16 * ti + li) * KS + 32 * ks + 8 * g);
#pragma unroll
            for (int vt = 0; vt < 8; ++vt) { const LAS bf16* p = Sx + (32 * ks + 8 * g + tq) * VS + 128 * vh + 16 * vt + 4 * tp; o[vt] = MFMA16(cat8(TR16(p), TR16(p + 4 * VS)), qf2, o[vt]); } }
        bf16x8 qf[4];
#pragma unroll
        for (int ks = 0; ks < 4; ++ks) qf[ks] = *(const LAS bf16x8*)(QT + (16 * ti + li) * KS + 32 * ks + 8 * g);
        __syncthreads();
        unsigned long long rraw[8];
        const size_t mtok = mq + 16 * ti + li;
        for (int jc = 0; jc <= nl; ++jc) {
            {
                const unsigned kw[8] = {R.k0.x, R.k0.y, R.k0.z, R.k0.w, R.k1.x, R.k1.y, R.k1.z, R.k1.w};
                float gg[16]; unpack_h8(R.g[0], gg); unpack_h8(R.g[1], gg + 8);
                unsigned o1[8];
#pragma unroll
                for (int e2 = 0; e2 < 8; ++e2) o1[e2] = pg8::cvt_pk_bf16(bflo(kw[e2]) * fexp(cpre[2 * e2] - gg[2 * e2]), bfhi(kw[e2]) * fexp(cpre[2 * e2 + 1] - gg[2 * e2 + 1]));
                LAS v4u* d1 = (LAS v4u*)(KT + srow * KS + spc * 16); d1[0] = (v4u){o1[0], o1[1], o1[2], o1[3]}; d1[1] = (v4u){o1[4], o1[5], o1[6], o1[7]};
#pragma unroll
                for (int r = 0; r < 4; ++r) { const int idx = tid + 512 * r, row = idx >> 5, pc = idx & 31; *(LAS v4u*)(Vs + row * VS + pc * 8) = R.v[r]; }
#pragma unroll
                for (int e2 = 0; e2 < 16; ++e2) cpre[e2] -= CT[jc * 128 + spc * 16 + e2];
            }
            __syncthreads();
            if (jc < nl) g3_load_raw(R, PROJ, GB, m0 + (jc + 1) * 64, h, srow, spc, tid);
            else {
#pragma unroll
                for (int vt = 0; vt < 8; ++vt) rraw[vt] = *(const unsigned long long*)(PROJ + mtok * NPROJ + O_R + h * 256 + 128 * vh + 16 * vt + 4 * g); }
            f32x4 sc[4];
#pragma unroll
            for (int jt = 0; jt < 4; ++jt) { sc[jt] = (f32x4){0.f, 0.f, 0.f, 0.f};
#pragma unroll
                for (int ks = 0; ks < 4; ++ks) sc[jt] = MFMA16(*(const LAS bf16x8*)(KT + (16 * jt + li) * KS + 32 * ks + 8 * g), qf[ks], sc[jt]); }
            if (jc == nl) {
#pragma unroll
                for (int jt = 0; jt < 4; ++jt)
#pragma unroll
                    for (int r = 0; r < 4; ++r) if (16 * jt + 4 * g + r > 16 * ti + li) sc[jt][r] = 0.f; }
#pragma unroll
            for (int k2 = 0; k2 < 2; ++k2) { const f32x4 s0 = sc[2 * k2], s1 = sc[2 * k2 + 1];
                v4u pw; pw.x = pg8::cvt_pk_bf16(s0[0], s0[1]); pw.y = pg8::cvt_pk_bf16(s0[2], s0[3]); pw.z = pg8::cvt_pk_bf16(s1[0], s1[1]); pw.w = pg8::cvt_pk_bf16(s1[2], s1[3]);
                const bf16x8 pf = __builtin_bit_cast(bf16x8, pw);
#pragma unroll
                for (int vt = 0; vt < 8; ++vt) { const LAS bf16* p = Vs + (32 * k2 + 4 * g + tq) * VS + 128 * vh + 16 * vt + 4 * tp; o[vt] = MFMA16(cat8(TR16(p), TR16(p + 16 * VS)), pf, o[vt]); } }
            __syncthreads();
        }
        float a = 0.f;
#pragma unroll
        for (int vt = 0; vt < 8; ++vt) a += (o[vt][0] * o[vt][0] + o[vt][1] * o[vt][1]) + (o[vt][2] * o[vt][2] + o[vt][3] * o[vt][3]);
        a += __shfl_xor(a, 16); a += __shfl_xor(a, 32);
        if (g == 0) RED[(16 * ti + li) * 2 + vh] = a;
        __syncthreads();
        const float rstd = __builtin_amdgcn_rsqf((RED[(16 * ti + li) * 2] + RED[(16 * ti + li) * 2 + 1]) * (1.f / 256.f) + EPS);
        bf16* yp = Y + mtok * D + 1024 + h * 256 + 128 * vh + 4 * g;
#pragma unroll
        for (int vt = 0; vt < 8; ++vt) { const f32x4 gv = *(const f32x4*)(gn + 128 * vh + 16 * vt + 4 * g); const unsigned long long rw = rraw[vt];
            const float r0 = bflo((unsigned)rw), r1 = bfhi((unsigned)rw), r2 = bflo((unsigned)(rw >> 32)), r3 = bfhi((unsigned)(rw >> 32));
            const float y0 = o[vt][0] * rstd * gv.x * r0 * __builtin_amdgcn_rcpf(1.f + fexp(-r0)), y1 = o[vt][1] * rstd * gv.y * r1 * __builtin_amdgcn_rcpf(1.f + fexp(-r1));
            const float y2 = o[vt][2] * rstd * gv.z * r2 * __builtin_amdgcn_rcpf(1.f + fexp(-r2)), y3 = o[vt][3] * rstd * gv.w * r3 * __builtin_amdgcn_rcpf(1.f + fexp(-r3));
            *(unsigned long long*)(yp + 16 * vt) = (unsigned long long)pg8::cvt_pk_bf16(y0, y1) | ((unsigned long long)pg8::cvt_pk_bf16(y2, y3) << 32); }
    }
}
constexpr int AKS = 136;
constexpr int ASLOT = 2 * 128 * AKS;
constexpr int KVP = 6144;
template <int DIL> __device__ __forceinline__ void attn_load_block(v4u (&R)[4], const char* ubase, bool valid, unsigned loff) {
#pragma unroll
    for (int it = 0; it < 4; ++it) { R[it] = (v4u){0u, 0u, 0u, 0u};
        if (valid) R[it] = *(const v4u*)(ubase + (size_t)(64 * (it & 1)) * DIL * KVP + (it >> 1) * 2048 + loff); }
}
typedef float f32x2_ __attribute__((ext_vector_type(2)));
__device__ __forceinline__ unsigned fp8lo_to_bf16(unsigned w) { const f32x2_ a = __builtin_amdgcn_cvt_pk_f32_fp8((int)w, false); return pg8::cvt_pk_bf16(a[0], a[1]); }
__device__ __forceinline__ unsigned fp8hi_to_bf16(unsigned w) { const f32x2_ a = __builtin_amdgcn_cvt_pk_f32_fp8((int)w, true); return pg8::cvt_pk_bf16(a[0], a[1]); }
__device__ __forceinline__ void attn_store_block(const v4u (&R)[4], LAS bf16* slot, int tid) {
#pragma unroll
    for (int it = 0; it < 4; ++it) { const int kv = it >> 1, row = (tid >> 3) + 64 * (it & 1), pc = tid & 7; v4u a, b;
        a.x = fp8lo_to_bf16(R[it].x); a.y = fp8hi_to_bf16(R[it].x); a.z = fp8lo_to_bf16(R[it].y); a.w = fp8hi_to_bf16(R[it].y); b.x = fp8lo_to_bf16(R[it].z); b.y = fp8hi_to_bf16(R[it].z); b.z = fp8lo_to_bf16(R[it].w); b.w = fp8hi_to_bf16(R[it].w);
        LAS bf16* d = slot + kv * (128 * AKS) + row * AKS + pc * 16; *(LAS v4u*)d = a; *(LAS v4u*)(d + 8) = b; }
}
__device__ __forceinline__ bf16x8 q8_to_bf16(unsigned long long raw) { const unsigned lo = (unsigned)raw, hi = (unsigned)(raw >> 32);
    v4u o; o.x = fp8lo_to_bf16(lo); o.y = fp8hi_to_bf16(lo); o.z = fp8lo_to_bf16(hi); o.w = fp8hi_to_bf16(hi); return __builtin_bit_cast(bf16x8, o); }
template <int GI, bool MERGE> __device__ __forceinline__ void attn_chain(Frame& F, const int bh, const int r, const int blk0, const int nblk) {
    constexpr int DIL = (GI == 0) ? 16 : (GI == 1 ? 4 : 1);
    const bf16* PROJ = (const bf16*)(F.ws + WS_PROJ); bf16* Y = (bf16*)(F.ws + WS_Y); float* LSE = (float*)(F.ws + WS_GLOW);
    LAS bf16* S0 = (LAS bf16*)(F.lds);
    const int tid = F.tid, w = F.wave, qi0 = 16 * w;
    constexpr float L2E = 1.4426950408889634f, LN2 = 0.6931471805599453f, QK2 = 0.08838834764831845f * L2E;
    const unsigned loff = (unsigned)((tid >> 3) * DIL * KVP + (tid & 7) * 16);
    { const int b = bh >> 4, h = bh & 15;
        const float slope2 = exp2f(-0.5f * (float)(h + 1)) * (float)DIL * L2E;
        const size_t rowb = (size_t)b * T;
        const unsigned char* QKV8 = F.ws + WS_PROJ; const char* kvbase = (const char*)QKV8 + (rowb + r) * KVP + 2048 + h * 128;
        int par = 0;
        v4u R[4]; bf16x8 qf[4]; unsigned long long qnr[4];
        {
            v4u R2[4];
            attn_load_block<DIL>(R2, kvbase + (ptrdiff_t)(blk0 - 1) * 128 * DIL * KVP, blk0 > 0, loff);
            attn_load_block<DIL>(R, kvbase + (ptrdiff_t)blk0 * 128 * DIL * KVP, true, loff);
            const unsigned char* qp = QKV8 + (rowb + (size_t)(blk0 * 128 + qi0) * DIL + r + (size_t)(F.lane & 15) * DIL) * KVP + h * 128 + 8 * (F.lane >> 4);
#pragma unroll
            for (int ks = 0; ks < 4; ++ks) qnr[ks] = *(const unsigned long long*)(qp + 32 * ks);
#pragma unroll
            for (int ks = 0; ks < 4; ++ks) qf[ks] = q8_to_bf16(qnr[ks]);
            attn_store_block(R2, S0 + ASLOT, tid); attn_store_block(R, S0, tid); }
        __syncthreads();
        for (int i = 0; i < nblk; ++i) { const int blk = blk0 + i;
            int g = F.lane >> 4, li = F.lane & 15;
            asm volatile("" : "+v"(g), "+v"(li));
            const int lk = li * AKS + 8 * g, lv = (4 * g + (li >> 2)) * AKS + 4 * (li & 3), bd = 128 + li - 4 * g;
            const size_t mq0 = rowb + (size_t)(blk * 128 + qi0) * DIL + r;
            bf16* yp = Y + mq0 * D + h * 128 + (li * DIL * D + 4 * g); float* lp_ = LSE + mq0 * 16 + h + li * DIL * 16;
            unsigned long long yo[8]; float lpv = 0.f;
            if (MERGE) { lpv = *lp_;
#pragma unroll
                for (int vt = 0; vt < 8; ++vt) yo[vt] = *(const unsigned long long*)(yp + 16 * vt); }
            if (i + 1 < nblk) { attn_load_block<DIL>(R, kvbase + (ptrdiff_t)(blk + 1) * 128 * DIL * KVP, true, loff);
                const unsigned char* qp = QKV8 + (mq0 + (size_t)128 * DIL + (size_t)li * DIL) * KVP + h * 128 + 8 * g;
#pragma unroll
                for (int ks = 0; ks < 4; ++ks) qnr[ks] = *(const unsigned long long*)(qp + 32 * ks); }
            const int curo = par * ASLOT, prvo = (par ^ 1) * ASLOT;
            f32x4 sc[9];
            {
                bf16x8 kf[2][4];
#define ATT_KLOAD(buf, jt_) do { const int ki0_ = qi0 + 16 * (jt_); const LAS bf16* kb_ = S0 + ((ki0_ < 128) ? prvo : curo) + (ki0_ & 127) * AKS + lk; \
                    _Pragma("unroll") for (int ks = 0; ks < 4; ++ks) kf[buf][ks] = *(const LAS bf16x8*)(kb_ + 32 * ks); } while (0)
                ATT_KLOAD(0, 0);
#pragma unroll
                for (int jt = 0; jt < 9; ++jt) {
                    if (jt + 1 < 9) ATT_KLOAD((jt + 1) & 1, jt + 1);
                    __builtin_amdgcn_sched_barrier(0);
                    sc[jt] = (f32x4){0.f, 0.f, 0.f, 0.f};
#pragma unroll
                    for (int ks = 0; ks < 4; ++ks) sc[jt] = MFMA16(kf[jt & 1][ks], qf[ks], sc[jt]);
                    __builtin_amdgcn_sched_barrier(0); }
#undef ATT_KLOAD
            }
            const float c0 = slope2 * (float)bd;
            float mx = -INFINITY;
            if (blk > 0) {
#pragma unroll
                for (int jt = 0; jt < 9; ++jt)
#pragma unroll
                    for (int rr = 0; rr < 4; ++rr) { float s = fmaf(sc[jt][rr], QK2, fmaf(slope2, (float)(16 * jt + rr), -c0));
                        if (jt == 0) s = (bd - rr <= 128) ? s : -INFINITY;
                        if (jt == 8) s = (bd - 128 - rr >= 0) ? s : -INFINITY;
                        sc[jt][rr] = s; mx = fmaxf(mx, s); }
            } else {
#pragma unroll
                for (int jt = 0; jt < 9; ++jt)
#pragma unroll
                    for (int rr = 0; rr < 4; ++rr) { const int diff = bd - (16 * jt + rr); const bool ok = (unsigned)diff <= (unsigned)(qi0 + li);
                        const float s = ok ? fmaf(sc[jt][rr], QK2, fmaf(slope2, (float)(16 * jt + rr), -c0)) : -INFINITY; sc[jt][rr] = s; mx = fmaxf(mx, s); }
            }
            mx = fmaxf(mx, __shfl_xor(mx, 16)); mx = fmaxf(mx, __shfl_xor(mx, 32));
            float z = 0.f;
#pragma unroll
            for (int jt = 0; jt < 9; ++jt)
#pragma unroll
                for (int rr = 0; rr < 4; ++rr) { const float p = __builtin_amdgcn_exp2f(sc[jt][rr] - mx); sc[jt][rr] = p; z += p; }
            z += __shfl_xor(z, 16); z += __shfl_xor(z, 32);
            f32x4 o[8];
#pragma unroll
            for (int vt = 0; vt < 8; ++vt) o[vt] = (f32x4){0.f, 0.f, 0.f, 0.f};
#pragma unroll
            for (int k2 = 0; k2 < 4; ++k2) { const f32x4 s0 = sc[2 * k2], s1 = sc[2 * k2 + 1];
                v4u pw; pw.x = pg8::cvt_pk_bf16(s0[0], s0[1]); pw.y = pg8::cvt_pk_bf16(s0[2], s0[3]); pw.z = pg8::cvt_pk_bf16(s1[0], s1[1]); pw.w = pg8::cvt_pk_bf16(s1[2], s1[3]);
                const bf16x8 pf = __builtin_bit_cast(bf16x8, pw);
                const int ka = qi0 + 32 * k2, kb2 = ka + 16;
                const LAS bf16* va = S0 + ((ka < 128) ? prvo : curo) + 128 * AKS + (ka & 127) * AKS + lv;
                const LAS bf16* vb = S0 + ((kb2 < 128) ? prvo : curo) + 128 * AKS + (kb2 & 127) * AKS + lv;
#pragma unroll
                for (int vt = 0; vt < 8; ++vt) o[vt] = MFMA16(cat8(TR16(va + 16 * vt), TR16(vb + 16 * vt)), pf, o[vt]); }
            {
                typedef unsigned u32x2v __attribute__((ext_vector_type(2)));
                u32x2v pw; pw.x = pg8::cvt_pk_bf16(sc[8][0], sc[8][1]); pw.y = pg8::cvt_pk_bf16(sc[8][2], sc[8][3]);
                const s16x4 pf4 = __builtin_bit_cast(s16x4, pw);
                const int ka = qi0 + 128; const LAS bf16* va = S0 + curo + 128 * AKS + (ka & 127) * AKS + lv;
#pragma unroll
                for (int vt = 0; vt < 8; ++vt) o[vt] = __builtin_amdgcn_mfma_f32_16x16x16bf16_1k(TR16(va + 16 * vt), pf4, o[vt], 0, 0, 0); }
            {
                float lnew = (mx + __builtin_amdgcn_logf(z)) * LN2, wn = 1.0f / z, wo = 0.f;
                if (MERGE) { const float lp = lpv; const float lq = lnew, mm = fmaxf(lp, lq); lnew = mm + __logf(__expf(lp - mm) + __expf(lq - mm)); wo = __expf(lp - lnew); wn = __expf(lq - lnew) / z; }
#pragma unroll
                for (int vt = 0; vt < 8; ++vt) { f32x4 val = o[vt] * wn;
                    if (MERGE) { const unsigned long long pv = yo[vt]; val[0] += wo * bflo((unsigned)pv); val[1] += wo * bfhi((unsigned)pv); val[2] += wo * bflo((unsigned)(pv >> 32)); val[3] += wo * bfhi((unsigned)(pv >> 32)); }
                    *(unsigned long long*)(yp + 16 * vt) = (unsigned long long)pg8::cvt_pk_bf16(val[0], val[1]) | ((unsigned long long)pg8::cvt_pk_bf16(val[2], val[3]) << 32); }
                if (g == 0) *lp_ = lnew; }
            __syncthreads();
            if (i + 1 < nblk) { attn_store_block(R, S0 + (par ^ 1) * ASLOT, tid); par ^= 1;
#pragma unroll
                for (int ks = 0; ks < 4; ++ks) qf[ks] = q8_to_bf16(qnr[ks]);
                __syncthreads(); }
        }
    }
}
__device__ __forceinline__ void attn_phase_a(Frame& F) {
    for (int u0 = F.vcu; u0 < 256; u0 += F.G) { const int bh = u0 >> 2, r4 = u0 & 3;
        attn_chain<1, false>(F, bh, r4, 0, 8);
        asm volatile("s_waitcnt vmcnt(0)" ::: "memory"); __syncthreads();
        for (int k = 0; k < 4; ++k) attn_chain<0, true>(F, bh, r4 + 4 * k, 0, 2); }
}
__device__ __forceinline__ void attn_phase_b(Frame& F) {
    for (int u0 = F.vcu; u0 < 256; u0 += F.G) attn_chain<2, true>(F, u0 >> 2, 0, 8 * (u0 & 3), 8);
}
__device__ __forceinline__ int fill_rf_table(Frame& F, const pg8::StaticOrder& S, int nunits, const unsigned long long* ssn, const unsigned long long* ssq, float qclip) {
    pg8::Unit ua, ub; S.next(0, ua); S.next(nunits / 2, ub);
    LAS float* rft = (LAS float*)(F.lds + RFT_OFF);
    const int row = ((F.tid < 256) ? ua.pm : ub.pm) * 256 + (F.tid & 255);
    rft[F.tid] = __builtin_amdgcn_rsqf((float)ssn[row] * (pg8::INV_D / 1048576.0f) + pg8::RMS_EPS) * pg8::rowq_inv(ssq[row], qclip);
    __syncthreads();
    return ua.pm;
}
struct Args { const float* in[14]; float* out; unsigned char* ws; int ph_lo, ph_hi; };
__global__ void __launch_bounds__(NWAVES * 64, 2) mk_fwd(Args args) {
    extern __shared__ __attribute__((aligned(16))) unsigned char lds[];
    Frame F;
    F.lds = (LAS unsigned char*)lds;
    F.MISC = (volatile LAS unsigned*)(F.lds + MISC_OFF);
    F.tid = threadIdx.x; F.lane = F.tid & 63; F.wave = __builtin_amdgcn_readfirstlane(F.tid >> 6);
    F.G = gridDim.x; { const int bx = blockIdx.x; F.vcu = (F.G % 8 == 0) ? (bx % 8) * (F.G / 8) + bx / 8 : bx; }
    F.ws = args.ws; F.out = args.out; F.ctl = (gu32*)(args.ws + WS_CTL);
#pragma unroll
    for (int i = 0; i < 14; ++i) F.in[i] = args.in[i];
    for (int u = F.tid; u < (LDS_BYTES - LDSCTL_OFF) / 4; u += NWAVES * 64) ((LAS unsigned*)(F.lds + LDSCTL_OFF))[u] = 0u;
    __syncthreads();
#if MK_PER_PHASE
#define GRID_BAR() do { } while (0)
#else
    XcdBarrier bar = xcd_barrier_post((unsigned*)(F.ctl + CW_BAR), F.MISC + 8, F.wave);
#define GRID_BAR() xcd_barrier(bar)
#endif
    const int lo = args.ph_lo, hi = args.ph_hi;
#ifndef MK_PHASE_MASK
#define MK_PHASE_MASK 0xFFFF
#endif
#define IN(k) (((MK_PHASE_MASK >> (k)) & 1) && lo <= (k) && (k) < hi)
#define BOTH(k) (IN(k) && IN((k) + 1))
#ifndef MK_AMP_MASK
#define MK_AMP_MASK 0
#endif
#ifndef MK_AMP_X
#define MK_AMP_X 4
#endif
#define PH_T0() F.lane = pg8::fresh_lane(); F.tid = F.wave * 64 + F.lane; const unsigned long long _t0 = (MK_AMP_MASK != 0) ? rt() : 0ull
#define PH_AMP(k) do { if ((MK_AMP_MASK >> (k)) & 1) { const unsigned long long _t1 = rt(); while (rt() - _t1 < (unsigned long long)MK_AMP_X * (_t1 - _t0)) __builtin_amdgcn_s_sleep(8); } } while (0)
    bf16* const WA = (bf16*)(F.ws + WS_WA); bf16* const WAo = (bf16*)(F.ws + WS_WA + 24 * MiB);
    bf16* const ACT = (bf16*)(F.ws + WS_ACT); bf16* const Y = (bf16*)(F.ws + WS_Y); bf16* const PROJ = (bf16*)(F.ws + WS_PROJ); bf16* const HB = (bf16*)(F.ws + WS_H);
    unsigned long long* const SS = (unsigned long long*)(F.ws + WS_CTL + SS_OFF);
    const float* const x = F.in[0]; const float* const g_mix = F.in[1]; const float* const g_mlp = F.in[2];

    if (IN(0)) { PH_T0(); p0_prologue(F); PH_AMP(0); if (BOTH(0)) GRID_BAR(); }
    if (IN(1)) { PH_T0();
        glow_mfma(F);
        pg8::Gemm g{ACT, WA, M, NPROJ, D}; pg8::StaticOrder S; S.init(M, NPROJ, F.G, (int)blockIdx.x);
        pg8::EpiProj0 E{PROJ, NPROJ};
        pg8::gemm_phase<pg8::EpiProj0, pg8::StaticOrder, PG8_ALIGN, PG8_SP2>(F.lds + RING_OFF, g, S, E, F.wave);
        PH_AMP(1); if (BOTH(1)) GRID_BAR();
    }
    if (IN(2)) { PH_T0(); if (blockIdx.x & 1) { conv_set_a(F); conv_mix(F); __syncthreads(); gla_g1(F); } else { gla_g1(F); __syncthreads(); conv_set_a(F); conv_mix(F); } PH_AMP(2); if (BOTH(2)) GRID_BAR(); }
    if (IN(3)) { PH_T0(); gla_g2(F); PH_AMP(3); if (BOTH(3)) GRID_BAR(); }
    if (IN(4)) { PH_T0(); if (blockIdx.x & 1) { conv_set_b(F); __syncthreads(); gla_g3(F); } else { gla_g3(F); __syncthreads(); conv_set_b(F); } PH_AMP(4); if (BOTH(4)) GRID_BAR(); }
    if (IN(5)) { PH_T0();
        pg8::Gemm g{Y, WAo, M, D, D}; pg8::StaticOrder S; S.init(M, D, F.G, (int)blockIdx.x, 4);
        quant_rows_i8(F, (const bf16*)(F.ws + WS_WB), (unsigned char*)F.out + OUT_W8A, (const unsigned*)(F.ws + WS_CTL + CMAX0_OFF), FF, D);
        pg8::EpiRes2<true, 2> E{x, ACT, SS, D, (unsigned char*)F.out + OUT_X8A, (const unsigned long long*)(F.ws + WS_CTL + SSX_OFF), CLIP_X1};
        pg8::gemm_phase<pg8::EpiRes2<true, 2>, pg8::StaticOrder, PG8_ALIGN, PG8_SP2>(F.lds + RING_OFF, g, S, E, F.wave);
        PH_AMP(5); if (BOTH(5)) GRID_BAR();
    }
    if (IN(6)) { PH_T0();
        pg8::Gemm g{(const bf16*)((unsigned char*)F.out + OUT_X8A), (const bf16*)((unsigned char*)F.out + OUT_W8A), M, FF, D}; pg8::StaticOrder S; S.init(M, FF, F.G, (int)blockIdx.x, 4, 1);
        const int pmA = fill_rf_table(F, S, 8, SS, (const unsigned long long*)(F.ws + WS_CTL + SSX_OFF), CLIP_X1);
        pg8::EpiI8<1> E{HB, FF, (const LAS float*)(F.lds + RFT_OFF), pmA, (const unsigned*)(F.ws + WS_CTL + CMAX0_OFF)};
        pg8::gemm_phase<pg8::EpiI8<1>, pg8::StaticOrder, PG8_ALIGN, PG8_SP2, 2>(F.lds + RING_OFF, g, S, E, F.wave);
        PH_AMP(6); if (BOTH(6)) GRID_BAR();
    }
    if (IN(7)) { PH_T0();
        pg8::Gemm g{HB, (bf16*)(F.ws + WS_WB + 32 * MiB), M, D, FF}; pg8::StaticOrder S; S.init(M, D, F.G, (int)blockIdx.x, 4);
        quant_rows_i8(F, WA, (unsigned char*)F.out + OUT_WQ8, (const unsigned*)(F.ws + WS_CTL + CMAXQ_OFF), NPROJ, D);
        pg8::EpiRes2<false, 2> E{ACT, ACT, SS + M, D, F.ws + WS_A8, SS, CLIP_X2};
        pg8::gemm_phase<pg8::EpiRes2<false, 2>, pg8::StaticOrder, PG8_ALIGN, PG8_SP2>(F.lds + RING_OFF, g, S, E, F.wave);
        PH_AMP(7); if (BOTH(7)) GRID_BAR();
    }
    if (IN(8)) { PH_T0();
        pg8::Gemm g{(const bf16*)(F.ws + WS_A8), (const bf16*)((unsigned char*)F.out + OUT_WQ8), M, NPROJ, D}; pg8::StaticOrder S; S.init(M, NPROJ, F.G, (int)blockIdx.x, 4);
        const int pmA = fill_rf_table(F, S, 6, SS + M, SS, CLIP_X2);
        pg8::EpiQkvI8 E{F.ws + WS_PROJ, (const LAS float*)(F.lds + RFT_OFF), pmA, (const unsigned*)(F.ws + WS_CTL + CMAXQ_OFF)};
        pg8::gemm_phase<pg8::EpiQkvI8, pg8::StaticOrder, PG8_ALIGN, PG8_SP2, 2>(F.lds + RING_OFF, g, S, E, F.wave);
        PH_AMP(8); if (BOTH(8)) GRID_BAR();
    }
    if (IN(9)) { PH_T0(); attn_phase_a(F); PH_AMP(9); if (BOTH(9)) GRID_BAR(); }
    if (IN(11)) { PH_T0(); attn_phase_b(F); PH_AMP(11); if (BOTH(11)) GRID_BAR(); }
    if (IN(12)) { PH_T0();
        pg8::Gemm g{Y, (const bf16*)((unsigned char*)F.out + OUT_WO), M, D, D}; pg8::StaticOrder S; S.init(M, D, F.G, (int)blockIdx.x, 4);
        quant_rows_i8(F, (const bf16*)(F.ws + WS_WC), (unsigned char*)F.out + OUT_W8A, (const unsigned*)(F.ws + WS_CTL + CMAX1_OFF), FF, D);
        pg8::EpiRes2<false, 2> E{ACT, ACT, SS + 2 * M, D, (unsigned char*)F.out + OUT_X8A, SS + M};
        pg8::gemm_phase<pg8::EpiRes2<false, 2>, pg8::StaticOrder, PG8_ALIGN, PG8_SP2>(F.lds + RING_OFF, g, S, E, F.wave);
        PH_AMP(12); if (BOTH(12)) GRID_BAR();
    }
    if (IN(13)) { PH_T0();
        pg8::Gemm g{(const bf16*)((unsigned char*)F.out + OUT_X8A), (const bf16*)((unsigned char*)F.out + OUT_W8A), M, FF, D}; pg8::StaticOrder S; S.init(M, FF, F.G, (int)blockIdx.x, 4, 1);
        const int pmA = fill_rf_table(F, S, 8, SS + 2 * M, SS + M, pg8::Q8_CLIP);
        pg8::EpiI8<1> E{HB, FF, (const LAS float*)(F.lds + RFT_OFF), pmA, (const unsigned*)(F.ws + WS_CTL + CMAX1_OFF)};
        pg8::gemm_phase<pg8::EpiI8<1>, pg8::StaticOrder, PG8_ALIGN, PG8_SP2, 2>(F.lds + RING_OFF, g, S, E, F.wave);
        PH_AMP(13); if (BOTH(13)) GRID_BAR();
    }
    if (IN(14)) { PH_T0();
        pg8::Gemm g{HB, (bf16*)(F.ws + WS_WC + 32 * MiB), M, D, FF}; pg8::StaticOrder S; S.init(M, D, F.G, (int)blockIdx.x, 4);
        pg8::EpiFinal E{ACT, F.out, F.in[3], SS, (unsigned*)(F.ws + WS_CTL + FCNT_OFF), D};
        E.ss = SS + 3 * (size_t)M;
        pg8::gemm_phase<pg8::EpiFinal, pg8::StaticOrder, PG8_ALIGN, PG8_SP2>(F.lds + RING_OFF, g, S, E, F.wave);
        PH_AMP(14);
    }
#undef IN
#undef BOTH
}

extern "C" void kernel_launch(void* const* d_in, const int* in_sizes, int n_in, void* d_out, int out_size, void* d_ws, size_t ws_size, hipStream_t stream) {
    static int grid = 0;
    if (grid == 0) {
        if (n_in != 14 || in_sizes[0] != M * D || out_size != M * D || ws_size < WS_END) { fprintf(stderr, "kernel_launch: unexpected shapes (n_in %d, in0 %d, out %d, ws %zu); nothing launched\n", n_in, n_in > 0 ? in_sizes[0] : -1, out_size, ws_size); grid = -1; return; }
        int dev = 0, cus = 0, per_cu = 0;
        if (hipGetDevice(&dev) != hipSuccess || hipDeviceGetAttribute(&cus, hipDeviceAttributeMultiprocessorCount, dev) != hipSuccess) { grid = -1; return; }
        if (hipFuncSetAttribute((const void*)mk_fwd, hipFuncAttributeMaxDynamicSharedMemorySize, LDS_BYTES) != hipSuccess) { fprintf(stderr, "kernel_launch: hipFuncSetAttribute failed\n"); grid = -1; return; }
        if (hipOccupancyMaxActiveBlocksPerMultiprocessor(&per_cu, (const void*)mk_fwd, NWAVES * 64, LDS_BYTES) != hipSuccess || per_cu < 1) { fprintf(stderr, "kernel_launch: occupancy query says %d\n", per_cu); }
        (void)hipGetLastError();
        grid = cus;
    }
    if (grid < 0) return;
    if (hipMemsetAsync((char*)d_ws + WS_CTL, 0, CTL_ZERO_BYTES, stream) != hipSuccess) return;
    Args a{};
    for (int i = 0; i < 14; ++i) a.in[i] = (const float*)d_in[i];
    a.out = (float*)d_out; a.ws = (unsigned char*)d_ws;
#if MK_PER_PHASE
    for (int p = 0; p < NPHASE; ++p) { a.ph_lo = p; a.ph_hi = p + 1; hipLaunchKernelGGL(mk_fwd, dim3(grid), dim3(NWAVES * 64), LDS_BYTES, stream, a); }
#else
    a.ph_lo = 0; a.ph_hi = NPHASE; hipLaunchKernelGGL(mk_fwd, dim3(grid), dim3(NWAVES * 64), LDS_BYTES, stream, a);
#endif
}
```
